# Optimizing an MI355X kernel written in HIP

```python
import jax, jax.numpy as jnp
from jax import lax
import numpy as np

D_MODEL = 1024
BATCH = 1
SEQ = 16384
DEPTH = 4

GRID_W = 64
CTX_LEN = 256
RET_HEADS = 4
RET_QK_HEAD = 128
RET_V_HEAD = 256
RET_QK_WIDTH = RET_HEADS * RET_QK_HEAD
RET_V_WIDTH = RET_HEADS * RET_V_HEAD
CONV_WIDTH = 1024
CONV_TAPS = 3
D_FF = 2816
CHUNK = 128
N_MOD = 9
ROPE_BASE = 10000.0
NORM_EPS = 1e-6
IN_SECTIONS = (RET_QK_WIDTH, RET_V_WIDTH, RET_QK_WIDTH, RET_V_WIDTH, CONV_WIDTH, CONV_WIDTH, CONV_WIDTH, D_MODEL, D_MODEL)
IN_WIDTH = 2 * RET_QK_WIDTH + 2 * RET_V_WIDTH + 3 * CONV_WIDTH + 2 * D_MODEL
KV_WIDTH = RET_QK_WIDTH + RET_V_WIDTH

kernel_name = "hybrid_retention_shortconv_macaron_dit"


def rmsnorm(h, w):
    hf = h.astype(jnp.float32)
    hf = hf * lax.rsqrt(jnp.mean(hf * hf, axis=-1, keepdims=True) + NORM_EPS)
    return (hf * w.astype(jnp.float32)).astype(h.dtype)


def head_rmsnorm(o):
    return o * lax.rsqrt(jnp.mean(o * o, axis=-1, keepdims=True) + NORM_EPS)


def adaln_params(cond, w_mod, b_mod):
    m = jax.nn.silu(cond) @ w_mod + b_mod
    return m.reshape(cond.shape[0], 1, N_MOD, D_MODEL)


def modulated_norm(h, w, mod, i):
    return rmsnorm(h, w) * (1.0 + mod[:, :, 3 * i + 1]) + mod[:, :, 3 * i]


def swiglu(y, w_up, w_down):
    a, b = jnp.split(y @ w_up, 2, axis=-1)
    return (jax.nn.silu(a) * b) @ w_down


def ffn_sublayer(h, mod, i, norm_w, w_up, w_down):
    y = modulated_norm(h, norm_w, mod, i)
    return h + 0.5 * mod[:, :, 3 * i + 2] * swiglu(y, w_up, w_down)


def split_projection(p):
    pieces = []
    start = 0
    for width in IN_SECTIONS:
        pieces.append(p[..., start:start + width])
        start += width
    return pieces


def to_heads(t):
    b, n, w = t.shape
    return t.reshape(b, n, RET_HEADS, w // RET_HEADS).transpose(0, 2, 1, 3)


def axial_rope(t, pos_row, pos_col):
    half = t.shape[-1] // 2
    n_freq = half // 2
    inv_freq = ROPE_BASE ** (-jnp.arange(n_freq, dtype=jnp.float32) / n_freq)

    def rotate(part, pos):
        ang = pos.astype(jnp.float32)[:, None] * inv_freq[None, :]
        cos, sin = jnp.cos(ang).astype(t.dtype), jnp.sin(ang).astype(t.dtype)
        a, b = part[..., :n_freq], part[..., n_freq:]
        return jnp.concatenate([a * cos - b * sin, a * sin + b * cos], axis=-1)

    return jnp.concatenate([rotate(t[..., :half], pos_row), rotate(t[..., half:], pos_col)], axis=-1)


def retention_chunked(q, k, v, log_gamma, s0):
    batch, heads, n, dk = q.shape
    dv = v.shape[-1]
    nc = n // CHUNK
    qf = q.astype(jnp.float32).reshape(batch, heads, nc, CHUNK, dk)
    kf = k.astype(jnp.float32).reshape(batch, heads, nc, CHUNK, dk)
    vf = v.astype(jnp.float32).reshape(batch, heads, nc, CHUNK, dv)
    lg = log_gamma.astype(jnp.float32)[:, None]
    idx = jnp.arange(CHUNK, dtype=jnp.float32)
    rel = idx[:, None] - idx[None, :]
    intra_decay = jnp.where(rel >= 0, jnp.exp(lg[:, :, None] * jnp.maximum(rel, 0.0)), 0.0)
    scores = jnp.einsum('bhnid,bhnjd->bhnij', qf, kf) * intra_decay[None, :, None]
    intra = jnp.einsum('bhnij,bhnje->bhnie', scores, vf)
    k_weight = jnp.exp(lg * (CHUNK - 1 - idx))
    chunk_kv = jnp.einsum('bhnjd,bhnje->bhnde', kf * k_weight[None, :, None, :, None], vf)
    chunk_decay = jnp.exp(lg[:, 0] * CHUNK)[None, :, None, None]

    def step(state, kv_c):
        return chunk_decay * state + kv_c, state

    _, prev_states = lax.scan(step, s0, jnp.moveaxis(chunk_kv, 2, 0))
    q_weight = jnp.exp(lg * (idx + 1.0))
    cross = jnp.einsum('bhnid,nbhde->bhnie', qf * q_weight[None, :, None, :, None], prev_states)
    return (intra + cross).reshape(batch, heads, n, dv)


def bidir_retention(q, k, v, log_decay, s0_f, s0_b):
    flip = lambda t: jnp.flip(t, axis=2)
    fwd = retention_chunked(q, k, v, log_decay[0], s0_f)
    bwd = retention_chunked(flip(q), flip(k), flip(v), log_decay[1], s0_b)
    return fwd + flip(bwd)


def context_states(k, v, log_decay):
    length = k.shape[2]
    pos = jnp.arange(length, dtype=jnp.float32)
    lg = log_decay.astype(jnp.float32)
    w_f = jnp.exp(lg[0][:, None] * (length - 1 - pos))
    w_b = jnp.exp(lg[1][:, None] * pos)
    kf, vf = k.astype(jnp.float32), v.astype(jnp.float32)
    s_f = jnp.einsum('bhld,bhle->bhde', kf * w_f[None, :, :, None], vf)
    s_b = jnp.einsum('bhld,bhle->bhde', kf * w_b[None, :, :, None], vf)
    return s_f, s_b


def short_conv(u, w):
    up = jnp.pad(u, ((0, 0), (1, 1), (0, 0)))
    return w[0] * up[:, :-2] + w[1] * up[:, 1:-1] + w[2] * up[:, 2:]


def mixer_merge(o_ret, g, conv_b, conv_c, conv_x, gate_ret, gate_conv, conv_w, w_ret_out, w_conv_out, w_out):
    b, h, n, dv = o_ret.shape
    o = head_rmsnorm(o_ret).transpose(0, 2, 1, 3).reshape(b, n, h * dv).astype(g.dtype)
    y_ret = (jax.nn.silu(g) * o) @ w_ret_out
    y_conv = (conv_b * short_conv(conv_c * conv_x, conv_w)) @ w_conv_out
    merged = jax.nn.sigmoid(gate_ret) * y_ret + jax.nn.sigmoid(gate_conv) * y_conv
    return merged @ w_out


def setup_inputs(seed: int = 0) -> dict:
    key = jax.random.key(seed)
    ks = jax.random.split(key, 20)

    def nrm(k, shape, scale=1.0):
        return jax.random.normal(k, shape, jnp.float32) * scale

    base_decay = jnp.log1p(-jnp.power(2.0, -5.0 - jnp.arange(RET_HEADS, dtype=jnp.float32)))
    return {
        "x": nrm(ks[0], (BATCH, SEQ, D_MODEL)),
        "c": nrm(ks[1], (BATCH, D_MODEL)),
        "ctx": nrm(ks[2], (BATCH, CTX_LEN, D_MODEL)),
        "c_ctx": nrm(ks[3], (D_MODEL,)),
        "norm_w": 1.0 + nrm(ks[4], (DEPTH, 3, D_MODEL), 0.05),
        "w_mod": nrm(ks[5], (DEPTH, D_MODEL, N_MOD * D_MODEL), 0.3 * D_MODEL ** -0.5),
        "b_mod": nrm(ks[6], (DEPTH, N_MOD * D_MODEL), 0.02),
        "ffn1_w_up": nrm(ks[7], (DEPTH, D_MODEL, 2 * D_FF), D_MODEL ** -0.5),
        "ffn1_w_down": nrm(ks[8], (DEPTH, D_FF, D_MODEL), D_FF ** -0.5),
        "w_in": nrm(ks[9], (DEPTH, D_MODEL, IN_WIDTH), D_MODEL ** -0.5),
        "ret_log_decay": base_decay[None, None, :] * (1.0 + nrm(ks[10], (DEPTH, 2, RET_HEADS), 0.05)),
        "conv_w": nrm(ks[11], (DEPTH, CONV_TAPS, CONV_WIDTH), CONV_TAPS ** -0.5),
        "w_ret_out": nrm(ks[12], (DEPTH, RET_V_WIDTH, D_MODEL), RET_V_WIDTH ** -0.5),
        "w_conv_out": nrm(ks[13], (DEPTH, CONV_WIDTH, D_MODEL), CONV_WIDTH ** -0.5),
        "w_out": nrm(ks[14], (DEPTH, D_MODEL, D_MODEL), D_MODEL ** -0.5),
        "ffn2_w_up": nrm(ks[15], (DEPTH, D_MODEL, 2 * D_FF), D_MODEL ** -0.5),
        "ffn2_w_down": nrm(ks[16], (DEPTH, D_FF, D_MODEL), D_FF ** -0.5),
        "final_norm_w": 1.0 + nrm(ks[17], (D_MODEL,), 0.05),
    }


def reference(x, c, ctx, c_ctx, norm_w, w_mod, b_mod, ffn1_w_up, ffn1_w_down, w_in, ret_log_decay,
              conv_w, w_ret_out, w_conv_out, w_out, ffn2_w_up, ffn2_w_down, final_norm_w):
    batch, n_lat, _ = x.shape
    ROWS = n_lat // GRID_W
    pos_row = jnp.repeat(jnp.arange(ROWS), GRID_W)
    pos_col = jnp.tile(jnp.arange(GRID_W), ROWS)
    zero_state = jnp.zeros((batch, RET_HEADS, RET_QK_HEAD, RET_V_HEAD), jnp.float32)
    k_scale = RET_QK_HEAD ** -0.5

    for l in range(DEPTH):
        last = l == DEPTH - 1
        mod_x = adaln_params(c, w_mod[l], b_mod[l])
        mod_c = adaln_params(c_ctx[None], w_mod[l], b_mod[l])

        x = ffn_sublayer(x, mod_x, 0, norm_w[l, 0], ffn1_w_up[l], ffn1_w_down[l])
        ctx = ffn_sublayer(ctx, mod_c, 0, norm_w[l, 0], ffn1_w_up[l], ffn1_w_down[l])

        yx = modulated_norm(x, norm_w[l, 1], mod_x, 1)
        yc = modulated_norm(ctx, norm_w[l, 1], mod_c, 1)
        px = split_projection(yx @ w_in[l])
        if last:
            kc_raw, vc_raw = jnp.split(yc @ w_in[l][:, :KV_WIDTH], [RET_QK_WIDTH], axis=-1)
        else:
            pc = split_projection(yc @ w_in[l])
            kc_raw, vc_raw = pc[0], pc[1]
        kc = to_heads(kc_raw) * k_scale
        vc = to_heads(vc_raw)
        s_f, s_b = context_states(kc, vc, ret_log_decay[l])

        kx = axial_rope(to_heads(px[0]) * k_scale, pos_row, pos_col)
        vx = to_heads(px[1])
        qx = axial_rope(to_heads(px[2]), pos_row, pos_col)
        o_x = bidir_retention(qx, kx, vx, ret_log_decay[l], s_f, s_b)
        x = x + mod_x[:, :, 5] * mixer_merge(o_x, *px[3:], conv_w[l], w_ret_out[l], w_conv_out[l], w_out[l])
        if not last:
            qc = to_heads(pc[2])
            o_c = bidir_retention(qc, kc, vc, ret_log_decay[l], zero_state, zero_state)
            ctx = ctx + mod_c[:, :, 5] * mixer_merge(o_c, *pc[3:], conv_w[l], w_ret_out[l], w_conv_out[l], w_out[l])

        x = ffn_sublayer(x, mod_x, 2, norm_w[l, 2], ffn2_w_up[l], ffn2_w_down[l])
        if not last:
            ctx = ffn_sublayer(ctx, mod_c, 2, norm_w[l, 2], ffn2_w_up[l], ffn2_w_down[l])

    return rmsnorm(x, final_norm_w)
```

```cpp
#include <hip/hip_runtime.h>
#include <hip/hip_cooperative_groups.h>
#include <cstdio>
namespace cg = cooperative_groups;

#define LAS __attribute__((address_space(3)))
typedef _Float16 h16;
typedef _Float16 h16x8 __attribute__((ext_vector_type(8)));
typedef _Float16 h16x4 __attribute__((ext_vector_type(4)));
typedef _Float16 h16x2 __attribute__((ext_vector_type(2)));
typedef float f32x4 __attribute__((ext_vector_type(4)));
typedef unsigned u32x4 __attribute__((ext_vector_type(4)));

#ifndef DUP_MASK
#define DUP_MASK 0
#endif
#ifndef N_SPLIT
#define N_SPLIT 0
#endif

constexpr int D = 1024, SEQ = 16384, CTX = 256, M = SEQ + CTX, DEPTH = 4, DFF = 2816, NUP = 5632;
constexpr int NCH = M / 128;
constexpr int PW = 6144, WNR = 7168;
constexpr int PC_K = 0, PC_Q = 512, PC_G = 1024, PC_CB = 2048, PC_U = 3072, PC_GR = 4096, PC_GC = 5120;
constexpr float LOG2E = 1.4426950408889634f;
constexpr float NEPS = 1e-6f;

constexpr size_t SZ_X = (size_t)M * D * 2;
constexpr size_t SZ_Y = (size_t)M * D * 2;
constexpr size_t SZ_H = (size_t)M * DFF * 2;
constexpr size_t SZ_SB = (size_t)NCH * 8 * 32768 * 2;
constexpr size_t SZ_KT = (size_t)512 * M * 2;
constexpr size_t SZ_P = (size_t)M * PW * 2;
constexpr size_t SZ_VT = (size_t)1024 * M * 2;
constexpr size_t SZ_AC = (size_t)M * 2048 * 2;
static_assert(SZ_SB + SZ_KT <= SZ_H, "alias");
constexpr size_t OFF_X = 0;
constexpr size_t OFF_Y = OFF_X + SZ_X;
constexpr size_t OFF_RA = OFF_Y + SZ_Y;
constexpr size_t OFF_P = OFF_RA + SZ_H;
constexpr size_t OFF_VT = OFF_P + SZ_P;
constexpr size_t OFF_AC = OFF_VT + SZ_VT;
constexpr size_t OFF_W = OFF_AC + SZ_AC;
constexpr size_t W_UP1 = 0, W_DN1 = W_UP1 + (size_t)NUP * D, W_KV = W_DN1 + (size_t)D * DFF, W_N = W_KV + (size_t)1536 * D,
                 W_RO = W_N + (size_t)WNR * D, W_CO = W_RO + (size_t)D * D, W_O = W_CO + (size_t)D * D, W_UP2 = W_O + (size_t)D * D,
                 W_DN2 = W_UP2 + (size_t)NUP * D, W_END = W_DN2 + (size_t)D * DFF;
constexpr size_t OFF_MOD = OFF_W + 2 * W_END * 2;
constexpr size_t OFF_ROPE = OFF_MOD + (size_t)4 * 2 * 9216 * 4;
constexpr size_t OFF_BAR = OFF_ROPE + (size_t)256 * 32 * 2 * 4;
constexpr size_t OFF_PART = OFF_BAR + 16384;
constexpr size_t OFF_MGC = OFF_PART + (size_t)11 * CTX * D * 4;
constexpr size_t WS_END = OFF_MGC + (size_t)2 * CTX * D * 2;
constexpr int LDS_BYTES = 147456;

struct Params {
    const float* x; const float* c; const float* ctx; const float* c_ctx; const float* norm_w; const float* w_mod; const float* b_mod;
    const float* f1u; const float* f1d; const float* w_in; const float* rld; const float* conv_w; const float* wro; const float* wco; const float* wo;
    const float* f2u; const float* f2d; const float* fnw;
    float* out; unsigned char* ws; int ph_lo, ph_hi;
};
struct Ctx : Params { int wv; };

__device__ __forceinline__ int opaque_tid(int wv) { asm volatile("" : "+s"(wv)); int t = wv * 64 + (int)__builtin_amdgcn_mbcnt_hi(~0u, __builtin_amdgcn_mbcnt_lo(~0u, 0u)); asm volatile("" : "+v"(t)); return t; }
__device__ __forceinline__ int opaque_bid() { int b = blockIdx.x; asm volatile("" : "+s"(b)); return b; }
__device__ __forceinline__ float wave_sum(float v) {
#pragma unroll
    for (int o = 1; o < 64; o <<= 1) v += __shfl_xor(v, o);
    return v;
}
__device__ __forceinline__ float sigm(float x) { return __builtin_amdgcn_rcpf(1.0f + __builtin_amdgcn_exp2f(-x * LOG2E)); }
__device__ __forceinline__ float silu(float x) { return x * sigm(x); }
__device__ __forceinline__ h16x4 cvt4(f32x4 v) { h16x4 o; o.x = (h16)v.x; o.y = (h16)v.y; o.z = (h16)v.z; o.w = (h16)v.w; return o; }

constexpr int BM = 256, BK = 64, HALF = 128, HTB = HALF * BK * 2;
__device__ __forceinline__ int lds_byte(int r, int c) { const int st = (r >> 4) * 2 + (c >> 5), rr = r & 15, cc = c & 31, ob = rr * 64 + cc * 2; return st * 1024 + (ob ^ (((ob >> 9) & 1) << 5)); }
__device__ __forceinline__ void stage_rc(int b, int& R, int& C) { const int st = b / 1024, sb = b % 1024, swz = sb ^ (((sb >> 9) & 1) << 5); R = (st >> 1) * 16 + swz / 64; C = (st & 1) * 32 + (swz % 64) / 2; }
__device__ __forceinline__ void tile_of(int L, int nM, int nN, int& pm, int& pn) {
    const int nwg = nM * nN; int wgid = L;
    { const int q = nwg / 8, r = nwg % 8, xcd = wgid % 8, off = wgid / 8; wgid = (xcd < r ? xcd * (q + 1) : r * (q + 1) + (xcd - r) * q) + off; }
    const int nig = 8 * nN, gid = wgid / nig, fm = gid * 8, gsz = (nM - fm) < 8 ? (nM - fm) : 8;
    pm = __builtin_amdgcn_readfirstlane(fm + ((wgid % nig) % gsz)); pn = __builtin_amdgcn_readfirstlane((wgid % nig) / gsz);
}

struct Unit { const char* A; const char* B; int pm, pn, part, nt; };
typedef f32x4 Acc[2][2][4][2];

enum { G_UP = 0, G_DN = 1, G_INP = 2, G_YG = 3, G_OUT = 4, G_YGC = 5 };

template <int KIND> struct Pol {
    const char* A; const char* B; const char* A2; const char* B2;
    int nM, nN, K, noctx;
    h16* X; const float* gate_lat; const float* gate_ctx; float gs;
    h16* O; h16* O2; h16* O3; const h16* P; const float* cosT; const float* sinT; float* PART;

    __device__ __forceinline__ bool next(int i, Unit& u, int bid) const {
        const int G = gridDim.x, c = bid;
        int L = i * G + c, part = 0;
        const size_t tstep = (size_t)BM * K * 2;
        u.nt = K / BK;
        if (KIND == G_YG) {
            const int Lp = (i >> 1) * G + c; if (Lp >= 256) return false;
            int pm, pn; tile_of(Lp, 64, 4, pm, pn); part = i & 1;
            u.pm = pm + 1; u.pn = pn; u.part = part; u.A = (part ? A2 : A) + (size_t)(pm + 1) * tstep; u.B = (part ? B2 : B) + (size_t)pn * tstep; return true;
        }
        if (KIND == G_YGC) {
            if (L >= 8) return false;
            part = L >> 2; u.pm = 0; u.pn = L & 3; u.part = 2 + part; u.A = part ? A2 : A; u.B = (part ? B2 : B) + (size_t)(L & 3) * tstep; return true;
        }
        if (KIND == G_DN || KIND == G_OUT) {
            const int nlat = 64 * 4, nsl = noctx ? 0 : ((KIND == G_OUT) ? 8 : K / 256);
            if (L >= nlat + 4 * nsl) return false;
            if (L >= nlat) { const int idx = L - nlat, pn = idx & 3, sl = idx >> 2;
                u.pm = 0; u.pn = pn; u.part = 1 + sl; u.nt = 4;
                if (KIND == G_OUT) { u.A = ((sl >> 2) ? B2 : A2) + (size_t)(sl & 3) * 512; u.B = B + (size_t)pn * tstep + (size_t)(sl & 3) * 512; }
                else { u.A = A + (size_t)sl * 512; u.B = B + (size_t)pn * tstep + (size_t)sl * 512; }
                return true; }
            int pm, pn; tile_of(L, 64, 4, pm, pn);
            u.pm = pm + 1; u.pn = pn; u.part = 0; u.A = A + (size_t)(pm + 1) * tstep; u.B = B + (size_t)pn * tstep; return true;
        }
        if (L >= nM * nN) return false;
        int pm, pn; tile_of(L, nM, nN, pm, pn);
        u.pm = pm; u.pn = pn; u.part = part;
        if (KIND == G_INP && pn >= 28) { u.A = A2 + (size_t)(pn - 28) * tstep; u.B = A + (size_t)pm * tstep; }
        else { u.A = A + (size_t)pm * tstep; u.B = B + (size_t)pn * tstep; }
        return true;
    }
    __device__ __forceinline__ bool keep(const Unit& u) const { return KIND == G_YG && u.part == 0; }

    __device__ __forceinline__ void epi(Acc& acc, const Unit& u, int wr, int wc, int fr, int fq) const {
        const int r0 = u.pm * BM + wr * 64 + fr;
        if (KIND == G_UP) {
            const int hc0 = u.pn * 128 + 32 * wc + 8 * fq;
#pragma unroll
            for (int ai = 0; ai < 2; ++ai)
#pragma unroll
                for (int m = 0; m < 4; ++m) { h16x8 o;
#pragma unroll
                    for (int n = 0; n < 2; ++n) { const f32x4 a = acc[ai][0][m][n], b = acc[ai][1][m][n];
#pragma unroll
                        for (int j = 0; j < 4; ++j) o[4 * n + j] = (h16)(silu(a[j]) * b[j]); }
                    *(h16x8*)(O + (size_t)(r0 + ai * HALF + m * 16) * DFF + hc0) = o; }
        } else if (KIND == G_DN || KIND == G_OUT) {
            const int c0 = u.pn * BM + wc * 32 + 8 * fq;
            const float* gate = (u.pm == 0) ? gate_ctx : gate_lat;
            f32x4 g[2][2];
#pragma unroll
            for (int bj = 0; bj < 2; ++bj)
#pragma unroll
                for (int n = 0; n < 2; ++n) g[bj][n] = *(const f32x4*)(gate + c0 + bj * HALF + n * 4) * gs;
            if (u.part) {
#pragma unroll
                for (int ai = 0; ai < 2; ++ai)
#pragma unroll
                    for (int m = 0; m < 4; ++m)
#pragma unroll
                        for (int bj = 0; bj < 2; ++bj)
#pragma unroll
                            for (int n = 0; n < 2; ++n)
                                *(f32x4*)(PART + (size_t)(u.part - 1) * CTX * D + (size_t)(r0 + ai * HALF + m * 16) * D + c0 + bj * HALF + n * 4) = g[bj][n] * acc[ai][bj][m][n];
            } else {
                h16x8 xv[2][4][2];
#pragma unroll
                for (int ai = 0; ai < 2; ++ai)
#pragma unroll
                    for (int m = 0; m < 4; ++m)
#pragma unroll
                        for (int bj = 0; bj < 2; ++bj) xv[ai][m][bj] = *(const h16x8*)(X + (size_t)(r0 + ai * HALF + m * 16) * D + c0 + bj * HALF);
#pragma unroll
                for (int ai = 0; ai < 2; ++ai)
#pragma unroll
                    for (int m = 0; m < 4; ++m)
#pragma unroll
                        for (int bj = 0; bj < 2; ++bj) { const h16x8 x = xv[ai][m][bj]; h16x8 o;
#pragma unroll
                            for (int j = 0; j < 4; ++j) { o[j] = (h16)((float)x[j] + g[bj][0][j] * acc[ai][bj][m][0][j]); o[4 + j] = (h16)((float)x[4 + j] + g[bj][1][j] * acc[ai][bj][m][1][j]); }
                            *(h16x8*)(X + (size_t)(r0 + ai * HALF + m * 16) * D + c0 + bj * HALF) = o; }
            }
        } else if (KIND == G_INP) {
            if (u.pn >= 28) {
                const int ft = u.pn - 28;
                const int t0 = u.pm * BM + wc * 32 + 4 * fq;
                if (ft < 2) {
                    const float ks = 0.08838834764831845f;
#pragma unroll
                    for (int bj = 0; bj < 2; ++bj) { f32x4 csk[2][2], snk[2][2];
#pragma unroll
                        for (int n = 0; n < 2; ++n)
#pragma unroll
                            for (int m = 0; m < 2; ++m) { csk[n][m] = (f32x4){1.f, 1.f, 1.f, 1.f}; snk[n][m] = (f32x4){0.f, 0.f, 0.f, 0.f};
                                if (u.pm > 0) { const int f = 16 * m + fr, nt = t0 + bj * HALF + n * 16 - CTX;
#pragma unroll
                                    for (int j = 0; j < 4; ++j) { const int pos = wr ? ((nt + j) & 63) : ((nt + j) >> 6); csk[n][m][j] = cosT[pos * 32 + f]; snk[n][m][j] = sinT[pos * 32 + f]; } } }
                        __builtin_amdgcn_sched_barrier(0);
#pragma unroll
                        for (int ai = 0; ai < 2; ++ai)
#pragma unroll
                            for (int n = 0; n < 2; ++n) { const int t = t0 + bj * HALF + n * 16;
#pragma unroll
                                for (int m = 0; m < 2; ++m) { const f32x4 a0 = acc[ai][bj][m][n] * ks, b0 = acc[ai][bj][m + 2][n] * ks;
                                    const f32x4 a = a0 * csk[n][m] - b0 * snk[n][m], b = a0 * snk[n][m] + b0 * csk[n][m];
                                    const int F = ft * 256 + ai * HALF + wr * 64 + 16 * m + fr;
                                    *(h16x4*)(O2 + (size_t)F * M + t) = cvt4(a); *(h16x4*)(O2 + (size_t)(F + 32) * M + t) = cvt4(b); } }
                        __builtin_amdgcn_sched_barrier(0); }
                } else {
#pragma unroll
                    for (int ai = 0; ai < 2; ++ai)
#pragma unroll
                        for (int m = 0; m < 4; ++m) { h16* rowp = O3 + (size_t)((ft - 2) * 256 + ai * HALF + wr * 64 + 16 * m + fr) * M + t0;
#pragma unroll
                            for (int bj = 0; bj < 2; ++bj)
#pragma unroll
                                for (int n = 0; n < 2; ++n) *(h16x4*)(rowp + bj * HALF + n * 16) = cvt4(acc[ai][bj][m][n]); }
                }
            } else if (u.pn < 4) {
                const float sc = (u.pn < 2) ? 0.08838834764831845f : 1.0f;
                const int phi0 = 64 * (wc >> 1) + 16 * (wc & 1) + 4 * fq, f0 = 16 * (wc & 1) + 4 * fq;
                const int cb = (u.pn < 2 ? PC_K : PC_Q) + (u.pn & 1) * 256 + phi0;
#pragma unroll
                for (int ai = 0; ai < 2; ++ai) { f32x4 csv[4], snv[4];
#pragma unroll
                    for (int m = 0; m < 4; ++m) { const int row = r0 + ai * HALF + m * 16; csv[m] = (f32x4){1.f, 1.f, 1.f, 1.f}; snv[m] = (f32x4){0.f, 0.f, 0.f, 0.f};
                        if (u.pm > 0) { const int nt = row - CTX, pos = (wc >> 1) ? (nt & 63) : (nt >> 6); csv[m] = *(const f32x4*)(cosT + pos * 32 + f0); snv[m] = *(const f32x4*)(sinT + pos * 32 + f0); } }
                    __builtin_amdgcn_sched_barrier(0);
#pragma unroll
                    for (int m = 0; m < 4; ++m) { const int row = r0 + ai * HALF + m * 16; const f32x4 cs = csv[m], sn = snv[m];
#pragma unroll
                        for (int bj = 0; bj < 2; ++bj) { const f32x4 a = acc[ai][bj][m][0] * sc, b = acc[ai][bj][m][1] * sc;
                            h16* op = O + (size_t)row * PW + cb + bj * HALF;
                            *(h16x4*)op = cvt4(a * cs - b * sn); *(h16x4*)(op + 32) = cvt4(a * sn + b * cs); } }
                    __builtin_amdgcn_sched_barrier(0); }
            } else if (u.pn >= 12 && u.pn < 20) {
                const int c0 = PC_U + (u.pn - 12) * 128 + wc * 32 + 8 * fq;
#pragma unroll
                for (int ai = 0; ai < 2; ++ai)
#pragma unroll
                    for (int m = 0; m < 4; ++m) { h16x8 o;
#pragma unroll
                        for (int j = 0; j < 4; ++j) { o[j] = (h16)(acc[ai][0][m][0][j] * acc[ai][1][m][0][j]); o[4 + j] = (h16)(acc[ai][0][m][1][j] * acc[ai][1][m][1][j]); }
                        *(h16x8*)(O + (size_t)(r0 + ai * HALF + m * 16) * PW + c0) = o; }
            } else {
                const int c0 = (u.pn < 12 ? u.pn * BM : PC_GR + (u.pn - 20) * BM) + wc * 32 + 8 * fq;
#pragma unroll
                for (int ai = 0; ai < 2; ++ai)
#pragma unroll
                    for (int m = 0; m < 4; ++m) { h16* rowp = O + (size_t)(r0 + ai * HALF + m * 16) * PW + c0;
#pragma unroll
                        for (int bj = 0; bj < 2; ++bj) { h16x8 o;
#pragma unroll
                            for (int j = 0; j < 4; ++j) { o[j] = (h16)acc[ai][bj][m][0][j]; o[4 + j] = (h16)acc[ai][bj][m][1][j]; }
                            *(h16x8*)(rowp + bj * HALF) = o; } }
            }
        } else if (KIND == G_YGC) {
            const int c0 = u.pn * BM + wc * 32 + 8 * fq;
            const h16* gp = P + (u.part == 2 ? PC_GR : PC_GC) + c0; h16* op = (u.part == 2 ? O2 : O3) + c0;
#pragma unroll
            for (int ai = 0; ai < 2; ++ai) { h16x8 gv[4][2];
#pragma unroll
                for (int m = 0; m < 4; ++m)
#pragma unroll
                    for (int bj = 0; bj < 2; ++bj) gv[m][bj] = *(const h16x8*)(gp + (size_t)(r0 + ai * HALF + m * 16) * PW + bj * HALF);
                __builtin_amdgcn_sched_barrier(0);
#pragma unroll
                for (int m = 0; m < 4; ++m) { const size_t row = (size_t)(r0 + ai * HALF + m * 16);
#pragma unroll
                    for (int bj = 0; bj < 2; ++bj) { const h16x8 g = gv[m][bj]; h16x8 o;
#pragma unroll
                        for (int n = 0; n < 2; ++n)
#pragma unroll
                            for (int j = 0; j < 4; ++j) o[4 * n + j] = (h16)(acc[ai][bj][m][n][j] * sigm(fmaxf((float)g[4 * n + j], -30.f)));
                        *(h16x8*)(op + row * D + bj * HALF) = o; } }
                __builtin_amdgcn_sched_barrier(0); }
        } else if (KIND == G_YG) {
            const int c0 = u.pn * BM + wc * 32 + 8 * fq;
            if (u.part == 0) {
#pragma unroll
                for (int ai = 0; ai < 2; ++ai) { h16x8 gr[4][2], gc[4][2];
#pragma unroll
                    for (int m = 0; m < 4; ++m)
#pragma unroll
                        for (int bj = 0; bj < 2; ++bj) { const h16* gp = P + (size_t)(r0 + ai * HALF + m * 16) * PW + c0 + bj * HALF;
                            gr[m][bj] = *(const h16x8*)(gp + PC_GR); gc[m][bj] = *(const h16x8*)(gp + PC_GC); }
                    __builtin_amdgcn_sched_barrier(0);
#pragma unroll
                    for (int m = 0; m < 4; ++m)
#pragma unroll
                        for (int bj = 0; bj < 2; ++bj)
#pragma unroll
                            for (int n = 0; n < 2; ++n) { f32x4 q;
#pragma unroll
                                for (int j = 0; j < 4; ++j) { const float er = __builtin_amdgcn_exp2f(-fmaxf((float)gr[m][bj][4 * n + j], -30.f) * LOG2E), ec = __builtin_amdgcn_exp2f(-fmaxf((float)gc[m][bj][4 * n + j], -30.f) * LOG2E);
                                    q[j] = (1.0f + ec) * __builtin_amdgcn_rcpf(1.0f + er); }
                                acc[ai][bj][m][n] = acc[ai][bj][m][n] * q; } }
            } else {
#pragma unroll
                for (int ai = 0; ai < 2; ++ai) { h16x8 gv[4][2];
#pragma unroll
                    for (int m = 0; m < 4; ++m)
#pragma unroll
                        for (int bj = 0; bj < 2; ++bj) gv[m][bj] = *(const h16x8*)(P + (size_t)(r0 + ai * HALF + m * 16) * PW + PC_GC + c0 + bj * HALF);
                    __builtin_amdgcn_sched_barrier(0);
#pragma unroll
                    for (int m = 0; m < 4; ++m) { const size_t row = (size_t)(r0 + ai * HALF + m * 16);
#pragma unroll
                        for (int bj = 0; bj < 2; ++bj) { const h16x8 gc = gv[m][bj]; h16x8 o;
#pragma unroll
                            for (int n = 0; n < 2; ++n)
#pragma unroll
                                for (int j = 0; j < 4; ++j) o[4 * n + j] = (h16)(acc[ai][bj][m][n][j] * sigm(fmaxf((float)gc[4 * n + j], -30.f)));
                            *(h16x8*)(O + row * D + c0 + bj * HALF) = o; } }
                    __builtin_amdgcn_sched_barrier(0); }
            }
        }
    }
};

template <class P_> __device__ __forceinline__ void gemm_phase(LAS unsigned char* lds, const P_& S, int wv_) {
    const int tid = opaque_tid(wv_), wid = __builtin_amdgcn_readfirstlane(tid >> 6), lane = tid & 63, wr = wid >> 2, wc = wid & 3, fr = lane & 15, fq = lane >> 4;
    const int K = S.K;
    unsigned voff[2];
#pragma unroll
    for (int i = 0; i < 2; ++i) { int R, C; stage_rc(tid * 16 + i * 8192, R, C); voff[i] = (unsigned)(R * K + C) * 2u; }
    const size_t kstep = (size_t)(BK * 2), hstep = (size_t)HALF * K * 2;
    const unsigned ldsw = (unsigned)wid * 1024u;
    const int aoff = lds_byte(wr * 64 + fr, fq * 8), boff = lds_byte(wc * 32 + fr, fq * 8);
#define G_SA(b, h) (((b) * 2 + (h)) * HTB)
#define G_SB(b, h) ((4 + (b) * 2 + (h)) * HTB)
#define G_STAGE(bufoff, gbase) do { _Pragma("unroll") for (int _i = 0; _i < 2; ++_i) \
        __builtin_amdgcn_global_load_lds((const unsigned*)((const char*)(gbase) + voff[_i]), (LAS unsigned*)(lds + (bufoff) + ldsw + _i * 8192), 16, 0, 0); } while (0)
#define G_LDA(dst, b, h) do { _Pragma("unroll") for (int m = 0; m < 4; ++m) _Pragma("unroll") for (int k = 0; k < 2; ++k) dst[m][k] = *(const LAS h16x8*)(lds + G_SA(b, h) + aoff + m * 2048 + k * 1024); } while (0)
#define G_LDB(dst, b, h) do { _Pragma("unroll") for (int n = 0; n < 2; ++n) _Pragma("unroll") for (int k = 0; k < 2; ++k) dst[n][k] = *(const LAS h16x8*)(lds + G_SB(b, h) + boff + n * 2048 + k * 1024); } while (0)
#define G_MMA(ai, bj, At, Bt) do { __builtin_amdgcn_s_setprio(1); _Pragma("unroll") for (int m = 0; m < 4; ++m) _Pragma("unroll") for (int n = 0; n < 2; ++n) _Pragma("unroll") for (int k = 0; k < 2; ++k) \
        acc[ai][bj][m][n] = __builtin_amdgcn_mfma_f32_16x16x32_f16(Bt[n][k], At[m][k], acc[ai][bj][m][n], 0, 0, 0); __builtin_amdgcn_s_setprio(0); } while (0)
#define G_WAIT_V(n) asm volatile("s_waitcnt vmcnt(" #n ")" ::: "memory")
#define G_WAIT_L(n) asm volatile("s_waitcnt lgkmcnt(" #n ")" ::: "memory")
#define G_BAR __builtin_amdgcn_s_barrier()
#define G_SCHED __builtin_amdgcn_sched_barrier(0)
    Unit cur, nxt; int ui = 0;
    const int bid = opaque_bid();
    if (!S.next(0, cur, bid)) return;
    Acc acc;
#pragma unroll
    for (int a = 0; a < 2; ++a)
#pragma unroll
        for (int b = 0; b < 2; ++b)
#pragma unroll
            for (int m = 0; m < 4; ++m)
#pragma unroll
                for (int n = 0; n < 2; ++n) acc[a][b][m][n] = (f32x4){0.f, 0.f, 0.f, 0.f};
    h16x8 At[4][2], B0[2][2], B1[2][2];
    const char* cA = cur.A; const char* cB = cur.B;
    G_STAGE(G_SB(0, 0), cB); G_STAGE(G_SA(0, 0), cA); G_STAGE(G_SB(0, 1), cB + hstep); G_STAGE(G_SA(0, 1), cA + hstep);
    if (wr == 1) G_BAR;
    G_WAIT_V(4); G_BAR;
    G_STAGE(G_SB(1, 0), cB + kstep); G_STAGE(G_SA(1, 0), cA + kstep); G_STAGE(G_SB(1, 1), cB + hstep + kstep);
    G_WAIT_V(6); G_BAR;
    for (;;) {
        const bool has_next = S.next(ui + 1, nxt, bid);
        const char* nA = has_next ? nxt.A : cA; const char* nB = has_next ? nxt.B : cB;
        const int nt = cur.nt;
        for (int t = 0; t < nt; t += 2) {
            const bool last = (t == nt - 2);
            const char* a1 = cA + (size_t)(t + 1) * kstep;
            const char* a2 = last ? nA : cA + (size_t)(t + 2) * kstep; const char* b2 = last ? nB : cB + (size_t)(t + 2) * kstep;
            const char* a3 = a2 + kstep; const char* b3 = b2 + kstep;
            G_LDB(B0, 0, 0); G_SCHED; G_LDA(At, 0, 0); G_STAGE(G_SA(1, 1), a1 + hstep);
            G_WAIT_L(8); G_BAR; G_WAIT_L(0); G_MMA(0, 0, At, B0); G_BAR; G_SCHED;
            G_LDB(B1, 0, 1); G_STAGE(G_SB(0, 0), b2);
            G_BAR; G_WAIT_L(0); G_MMA(0, 1, At, B1); G_BAR;
            G_LDA(At, 0, 1); G_STAGE(G_SA(0, 0), a2);
            G_BAR; G_WAIT_L(0); G_MMA(1, 0, At, B0); G_BAR; G_SCHED;
            G_STAGE(G_SB(0, 1), b2 + hstep);
            G_WAIT_V(6); G_BAR; G_MMA(1, 1, At, B1); G_BAR;
            G_LDB(B0, 1, 0); G_SCHED; G_LDA(At, 1, 0); G_STAGE(G_SA(0, 1), a2 + hstep);
            G_WAIT_L(8); G_BAR; G_WAIT_L(0); G_MMA(0, 0, At, B0); G_BAR; G_SCHED;
            G_LDB(B1, 1, 1); G_STAGE(G_SB(1, 0), b3);
            G_BAR; G_WAIT_L(0); G_MMA(0, 1, At, B1); G_BAR;
            G_LDA(At, 1, 1); G_STAGE(G_SA(1, 0), a3);
            G_BAR; G_WAIT_L(0); G_MMA(1, 0, At, B0); G_BAR; G_SCHED;
            G_STAGE(G_SB(1, 1), b3 + hstep);
            G_WAIT_V(6); G_BAR; G_MMA(1, 1, At, B1); G_BAR;
        }
        S.epi(acc, cur, wr, wc, fr, fq);
        if (!S.keep(cur)) {
#pragma unroll
            for (int a = 0; a < 2; ++a)
#pragma unroll
                for (int b = 0; b < 2; ++b)
#pragma unroll
                    for (int m = 0; m < 4; ++m)
#pragma unroll
                        for (int n = 0; n < 2; ++n) acc[a][b][m][n] = (f32x4){0.f, 0.f, 0.f, 0.f};
        }
        if (!has_next) break;
        cur = nxt; cA = nA; cB = nB; ++ui;
    }
    G_WAIT_V(0);
    if (wr == 0) G_BAR;
    G_BAR;
}

__device__ __forceinline__ void phase_setup(const Ctx& p, LAS unsigned char* lds) {
    const int tid = opaque_tid(p.wv), nb = gridDim.x, b = opaque_bid();
    float* cosT = (float*)(p.ws + OFF_ROPE); float* sinT = cosT + 256 * 32;
    for (int i = b * 512 + tid; i < 256 * 32; i += nb * 512) {
        const int pos = i >> 5, f = i & 31;
        const float inv = exp2f(-(float)f * (13.287712379549449f / 32.0f));
        const float ang = (float)pos * inv;
        const double rev = (double)ang * 0.15915494309189535;
        const float fr = (float)(rev - floor(rev));
        cosT[i] = __builtin_amdgcn_cosf(fr); sinT[i] = __builtin_amdgcn_sinf(fr);
    }
    float* mod = (float*)(p.ws + OFF_MOD);
    LAS float* red = (LAS float*)lds;
    for (int it = b; it < 4 * 144; it += nb) {
        const int l = it / 144, cgp = it % 144, ct = tid & 15, sl = tid >> 4;
        const float* wm = p.w_mod + (size_t)l * D * 9216 + cgp * 64 + ct * 4;
        f32x4 ax = {0.f, 0.f, 0.f, 0.f}, ac = {0.f, 0.f, 0.f, 0.f};
#pragma unroll 8
        for (int r = 0; r < 32; ++r) { const int i = sl * 32 + r; const float cx = p.c[i], cc = p.c_ctx[i];
            const float sx = cx / (1.0f + expf(-cx)), sc = cc / (1.0f + expf(-cc));
            const f32x4 w = *(const f32x4*)(wm + (size_t)i * 9216); ax += w * sx; ac += w * sc; }
        *(LAS f32x4*)(red + (sl * 16 + ct) * 8) = ax; *(LAS f32x4*)(red + (sl * 16 + ct) * 8 + 4) = ac;
        __syncthreads();
        if (tid < 128) { const int s = tid >> 6, cc = tid & 63, ct2 = cc >> 2, comp = cc & 3; float sum = 0.f;
#pragma unroll 8
            for (int q = 0; q < 32; ++q) sum += red[(q * 16 + ct2) * 8 + s * 4 + comp];
            const int col = cgp * 64 + cc; mod[(size_t)(l * 2 + s) * 9216 + col] = sum + p.b_mod[(size_t)l * 9216 + col]; }
        __syncthreads();
    }
}

__device__ __forceinline__ int slot32(int s32) { return 16 * ((s32 >> 2) & 1) + 4 * (s32 >> 3) + (s32 & 3); }
__device__ __forceinline__ int perm_row(int kind, int s) {
    if (kind == 1) { const int part = s / DFF, hidx = s % DFF, pn = hidx >> 7, rem = hidx & 127; return pn * 256 + part * 128 + (rem & ~31) + slot32(rem & 31); }
    if (kind == 2) { const int head = s >> 7, phi = s & 127; return head * 128 + 32 * (2 * (phi >> 6) + ((phi & 31) >> 4)) + 16 * ((phi & 63) >> 5) + (phi & 15); }
    if (kind == 3) return (s & ~31) + slot32(s & 31);
    if (kind == 4) { const int part = s >> 10, ch = s & 1023, t = ch >> 7, rem = ch & 127; return t * 256 + part * 128 + (rem & ~31) + slot32(rem & 31); }
    return s;
}
__device__ __forceinline__ void cvt_job(const float* W, int ldw, int c0, int ncols, int K, h16* WT, int kind, LAS float* scr, int gw, int NGW, int lane) {
    const int nblk = ncols / 32, nitems = (K / 64) * nblk;
    f32x4 pre[8];
    if (gw < nitems) { const int kb = gw / nblk, nbk = gw % nblk;
#pragma unroll
        for (int i = 0; i < 8; ++i) pre[i] = *(const f32x4*)(W + (size_t)(64 * kb + 8 * i + (lane >> 3)) * ldw + c0 + 32 * nbk + (lane & 7) * 4); }
    for (int item = gw; item < nitems; item += NGW) {
        const int kb = item / nblk, nbk = item % nblk, k0 = 64 * kb, n0 = 32 * nbk;
#pragma unroll
        for (int i = 0; i < 8; ++i) { const int kk = 8 * i + (lane >> 3), nn = (lane & 7) * 4; const f32x4 v = pre[i];
            scr[kk * 33 + nn] = v.x; scr[kk * 33 + nn + 1] = v.y; scr[kk * 33 + nn + 2] = v.z; scr[kk * 33 + nn + 3] = v.w; }
        if (item + NGW < nitems) { const int kb2 = (item + NGW) / nblk, nbk2 = (item + NGW) % nblk;
#pragma unroll
            for (int i = 0; i < 8; ++i) pre[i] = *(const f32x4*)(W + (size_t)(64 * kb2 + 8 * i + (lane >> 3)) * ldw + c0 + 32 * nbk2 + (lane & 7) * 4); }
        asm volatile("s_waitcnt lgkmcnt(0)" ::: "memory");
        const int c = lane & 7;
#pragma unroll
        for (int j = 0; j < 4; ++j) { const int n = (lane >> 3) + 8 * j; const LAS float* s = scr + (8 * c) * 33 + n;
            h16x8 o;
#pragma unroll
            for (int e = 0; e < 8; ++e) o[e] = (h16)s[e * 33];
            *(h16x8*)(WT + (size_t)perm_row(kind, n0 + n) * K + k0 + 8 * c) = o; }
        asm volatile("s_waitcnt lgkmcnt(0)" ::: "memory");
    }
}
__device__ __forceinline__ void phase_cvt(const Ctx& p, int l, LAS unsigned char* lds, int skip) {
    const int tid = opaque_tid(p.wv), wv = tid >> 6, lane = tid & 63, bid = opaque_bid(), gw = (bid - skip) * 8 + wv, NGW = ((int)gridDim.x - skip) * 8;
    if (bid < skip) return;
    LAS float* scr = (LAS float*)(lds + wv * 8448);
    h16* W = (h16*)(p.ws + OFF_W) + (size_t)(l & 1) * W_END;
    const float* win = p.w_in + (size_t)l * D * 8192;
    cvt_job(p.f1u + (size_t)l * D * NUP, NUP, 0, NUP, D, W + W_UP1, 1, scr, gw, NGW, lane);
    cvt_job(p.f1d + (size_t)l * DFF * D, D, 0, D, DFF, W + W_DN1, 3, scr, gw, NGW, lane);
    cvt_job(win, 8192, 0, 1536, D, W + W_KV, 0, scr, gw, NGW, lane);
    cvt_job(win, 8192, 0, 512, D, W + W_N, 2, scr, gw, NGW, lane);
    cvt_job(win, 8192, 1536, 512, D, W + W_N + (size_t)512 * D, 2, scr, gw, NGW, lane);
    cvt_job(win, 8192, 2048, 2048, D, W + W_N + (size_t)1024 * D, 3, scr, gw, NGW, lane);
    cvt_job(win, 8192, 4096, 2048, D, W + W_N + (size_t)3072 * D, 4, scr, gw, NGW, lane);
    cvt_job(win, 8192, 6144, 2048, D, W + W_N + (size_t)5120 * D, 3, scr, gw, NGW, lane);
    cvt_job(p.wro + (size_t)l * D * D, D, 0, D, D, W + W_RO, 3, scr, gw, NGW, lane);
    cvt_job(p.wco + (size_t)l * D * D, D, 0, D, D, W + W_CO, 3, scr, gw, NGW, lane);
    cvt_job(p.wo + (size_t)l * D * D, D, 0, D, D, W + W_O, 3, scr, gw, NGW, lane);
    cvt_job(p.f2u + (size_t)l * D * NUP, NUP, 0, NUP, D, W + W_UP2, 1, scr, gw, NGW, lane);
    cvt_job(p.f2d + (size_t)l * DFF * D, D, 0, D, DFF, W + W_DN2, 3, scr, gw, NGW, lane);
}

__device__ __forceinline__ void phase_norm(const Ctx& p, int l, int sub, int nsl, bool first = false) {
    const int tid = opaque_tid(p.wv), lane = tid & 63, gw = opaque_bid() * 8 + (tid >> 6), NGW = gridDim.x * 8;
    h16* X = (h16*)(p.ws + OFF_X); h16* Y = (h16*)(p.ws + OFF_Y); const float* PART = (const float*)(p.ws + OFF_PART);
    const float* nw = p.norm_w + (size_t)(l * 3 + sub) * D;
    const float* mod = (const float*)(p.ws + OFF_MOD);
    const float* ml = mod + (size_t)(l * 2) * 9216; const float* mc = ml + 9216;
#define NCOL(j) (8 * lane + 512 * ((j) >> 1) + 4 * ((j) & 1))
    f32x4 wl[4], sl4[4];
#pragma unroll
    for (int j = 0; j < 4; ++j) { const int col = NCOL(j);
        wl[j] = *(const f32x4*)(nw + col) * (*(const f32x4*)(ml + (3 * sub + 1) * D + col) + 1.0f); sl4[j] = *(const f32x4*)(ml + (3 * sub) * D + col); }
    h16x8 tn[2];
    if (!first && gw < M) { tn[0] = *(const h16x8*)(X + (size_t)gw * D + 8 * lane); tn[1] = *(const h16x8*)(X + (size_t)gw * D + 8 * lane + 512); }
    for (int row = gw; row < M; row += NGW) {
        h16* xrow = X + (size_t)row * D; h16* yrow = Y + (size_t)row * D;
        f32x4 v[4]; float ss = 0.f;
        if (first) { const float* x32 = row < CTX ? p.ctx + (size_t)row * D : p.x + (size_t)(row - CTX) * D;
#pragma unroll
            for (int j = 0; j < 4; ++j) v[j] = *(const f32x4*)(x32 + NCOL(j));
#pragma unroll
            for (int q = 0; q < 2; ++q) { h16x8 o;
#pragma unroll
                for (int e = 0; e < 4; ++e) { o[e] = (h16)v[2 * q][e]; o[4 + e] = (h16)v[2 * q + 1][e]; }
                *(h16x8*)(xrow + 8 * lane + 512 * q) = o; }
        } else {
#pragma unroll
            for (int q = 0; q < 2; ++q) { const h16x8 t = tn[q];
#pragma unroll
                for (int e = 0; e < 4; ++e) { v[2 * q][e] = (float)t[e]; v[2 * q + 1][e] = (float)t[4 + e]; } }
            if (row + NGW < M) { tn[0] = *(const h16x8*)(xrow + (size_t)NGW * D + 8 * lane); tn[1] = *(const h16x8*)(xrow + (size_t)NGW * D + 8 * lane + 512); }
        }
        const bool isctx = row < CTX;
        if (isctx && nsl > 0) {
            for (int s0 = 0; s0 < nsl; s0 += 4) { f32x4 pv[4][4];
#pragma unroll
                for (int q = 0; q < 4; ++q) { const int sl = (s0 + q < nsl) ? s0 + q : nsl - 1; const float* pr = PART + (size_t)sl * CTX * D + (size_t)row * D;
#pragma unroll
                    for (int j = 0; j < 4; ++j) pv[q][j] = *(const f32x4*)(pr + NCOL(j)); }
#pragma unroll
                for (int q = 0; q < 4; ++q) if (s0 + q < nsl) {
#pragma unroll
                    for (int j = 0; j < 4; ++j) v[j] += pv[q][j]; } }
#pragma unroll
            for (int q = 0; q < 2; ++q) { h16x8 o;
#pragma unroll
                for (int e = 0; e < 4; ++e) { o[e] = (h16)v[2 * q][e]; o[4 + e] = (h16)v[2 * q + 1][e]; }
                *(h16x8*)(xrow + 8 * lane + 512 * q) = o; }
        }
#pragma unroll
        for (int j = 0; j < 4; ++j) ss += v[j].x * v[j].x + v[j].y * v[j].y + v[j].z * v[j].z + v[j].w * v[j].w;
        ss = wave_sum(ss);
        const float rs = __builtin_amdgcn_rsqf(ss * (1.0f / D) + NEPS);
        f32x4 y[4];
        if (isctx) {
#pragma unroll
            for (int j = 0; j < 4; ++j) { const int col = NCOL(j);
                const f32x4 w = *(const f32x4*)(nw + col), sc = *(const f32x4*)(mc + (3 * sub + 1) * D + col), sh = *(const f32x4*)(mc + (3 * sub) * D + col);
                y[j] = (v[j] * rs) * w * (sc + 1.0f) + sh; }
        } else {
#pragma unroll
            for (int j = 0; j < 4; ++j) y[j] = (v[j] * rs) * wl[j] + sl4[j];
        }
#pragma unroll
        for (int q = 0; q < 2; ++q) { h16x8 o;
#pragma unroll
            for (int e = 0; e < 4; ++e) { o[e] = (h16)y[2 * q][e]; o[4 + e] = (h16)y[2 * q + 1][e]; }
            *(h16x8*)(yrow + 8 * lane + 512 * q) = o; }
    }
#undef NCOL
}
__device__ __forceinline__ void phase_final(const Ctx& p) {
    const int tid = opaque_tid(p.wv), lane = tid & 63, gw = opaque_bid() * 8 + (tid >> 6), NGW = gridDim.x * 8;
    const h16* X = (const h16*)(p.ws + OFF_X);
    f32x4 fw[4];
#pragma unroll
    for (int j = 0; j < 4; ++j) fw[j] = *(const f32x4*)(p.fnw + 8 * lane + 512 * (j >> 1) + 4 * (j & 1));
    h16x8 tn[2];
    if (gw < SEQ) { tn[0] = *(const h16x8*)(X + (size_t)(gw + CTX) * D + 8 * lane); tn[1] = *(const h16x8*)(X + (size_t)(gw + CTX) * D + 8 * lane + 512); }
    for (int row = gw; row < SEQ; row += NGW) {
        const h16* xrow = X + (size_t)(row + CTX) * D;
        f32x4 v[4]; float ss = 0.f;
        const h16x8 tc0 = tn[0], tc1 = tn[1];
        if (row + NGW < SEQ) { tn[0] = *(const h16x8*)(xrow + (size_t)NGW * D + 8 * lane); tn[1] = *(const h16x8*)(xrow + (size_t)NGW * D + 8 * lane + 512); }
#pragma unroll
        for (int q = 0; q < 2; ++q) { const h16x8 t = q ? tc1 : tc0;
#pragma unroll
            for (int e = 0; e < 4; ++e) { v[2 * q][e] = (float)t[e]; v[2 * q + 1][e] = (float)t[4 + e]; } }
#pragma unroll
        for (int j = 0; j < 4; ++j) ss += v[j].x * v[j].x + v[j].y * v[j].y + v[j].z * v[j].z + v[j].w * v[j].w;
        ss = wave_sum(ss);
        const float rs = __builtin_amdgcn_rsqf(ss * (1.0f / D) + NEPS);
#pragma unroll
        for (int j = 0; j < 4; ++j) { const int col = 8 * lane + 512 * (j >> 1) + 4 * (j & 1);
            *(f32x4*)(p.out + (size_t)row * D + col) = (v[j] * rs) * fw[j]; }
    }
}

#define MFMA16(a, b, c) __builtin_amdgcn_mfma_f32_16x16x32_f16(a, b, c, 0, 0, 0)

__device__ __forceinline__ void phase_kv(const Ctx& p, int l, LAS unsigned char* lds) {
    const int tid = opaque_tid(p.wv), w = tid >> 6, lane = tid & 63, fr = lane & 15, fq = lane >> 4, bid = opaque_bid();
    LAS h16* Vs = (LAS h16*)lds; LAS h16* Kf = Vs + 256 * 136; LAS h16* Kb = Kf + 128 * 136; LAS float* wt = (LAS float*)(Kb + 128 * 136);
    const h16* kT = (const h16*)(p.ws + OFF_RA + SZ_SB); const h16* vT = (const h16*)(p.ws + OFF_VT); h16* SB = (h16*)(p.ws + OFF_RA);
    u32x4 vreg[8]; h16x8 kreg[4];
#define KV_ISSUE(uu) do { const int _c = (uu) >> 2, _h = (uu) & 3; \
        _Pragma("unroll") for (int i = 0; i < 8; ++i) { const int ch = tid + 512 * i, r = ch >> 4, cc = ch & 15; vreg[i] = *(const u32x4*)(vT + (size_t)(_h * 256 + r) * M + _c * 128 + cc * 8); } \
        _Pragma("unroll") for (int i = 0; i < 4; ++i) { const int ch = tid + 512 * i, r = ch >> 4, cc = ch & 15; kreg[i] = *(const h16x8*)(kT + (size_t)(_h * 128 + r) * M + _c * 128 + cc * 8); } } while (0)
    if (bid < NCH * 4) KV_ISSUE(bid);
    for (int u = bid; u < NCH * 4; u += gridDim.x) {
        const int c = u >> 2, h = u & 3;
        const float lgf = p.rld[(l * 2 + 0) * 4 + h] * LOG2E, lgb = p.rld[(l * 2 + 1) * 4 + h] * LOG2E;
        if (tid < 128) { wt[tid] = exp2f(lgf * (float)(127 - tid)); wt[128 + tid] = exp2f(lgb * (float)tid); }
#pragma unroll
        for (int i = 0; i < 8; ++i) { const int ch = tid + 512 * i, r = ch >> 4, cc = ch & 15; *(LAS u32x4*)(Vs + r * 136 + cc * 8) = vreg[i]; }
        __syncthreads();
#pragma unroll
        for (int i = 0; i < 4; ++i) { const int ch = tid + 512 * i, r = ch >> 4, cc = ch & 15, rs = (r & ~31) + slot32(r & 31);
            const h16x8 k = kreg[i]; h16x8 a, b2;
#pragma unroll
            for (int e = 0; e < 8; ++e) { const float kv = (float)k[e]; a[e] = (h16)(kv * wt[cc * 8 + e]); b2[e] = (h16)(kv * wt[128 + cc * 8 + e]); }
            *(LAS h16x8*)(Kf + rs * 136 + cc * 8) = a; *(LAS h16x8*)(Kb + rs * 136 + cc * 8) = b2; }
        __syncthreads();
        if (u + (int)gridDim.x < NCH * 4) KV_ISSUE(u + (int)gridDim.x);
#pragma unroll 1
        for (int dir = 0; dir < 2; ++dir) {
            const LAS h16* Kd = dir ? Kb : Kf;
            f32x4 acc[2][8];
#pragma unroll
            for (int a = 0; a < 2; ++a)
#pragma unroll
                for (int b = 0; b < 8; ++b) acc[a][b] = (f32x4){0.f, 0.f, 0.f, 0.f};
#pragma unroll
            for (int ks = 0; ks < 4; ++ks) { h16x8 vf[2];
#pragma unroll
                for (int ef = 0; ef < 2; ++ef) vf[ef] = *(const LAS h16x8*)(Vs + (32 * w + 16 * ef + fr) * 136 + ks * 32 + fq * 8);
#pragma unroll
                for (int df = 0; df < 8; ++df) { const h16x8 a = *(const LAS h16x8*)(Kd + (16 * df + fr) * 136 + ks * 32 + fq * 8);
#pragma unroll
                    for (int ef = 0; ef < 2; ++ef) acc[ef][df] = MFMA16(a, vf[ef], acc[ef][df]); } }
#pragma unroll
            for (int ef = 0; ef < 2; ++ef)
#pragma unroll
                for (int dp = 0; dp < 4; ++dp) { h16x8 o;
#pragma unroll
                    for (int j = 0; j < 4; ++j) { o[j] = (h16)acc[ef][2 * dp][j]; o[4 + j] = (h16)acc[ef][2 * dp + 1][j]; }
                    *(h16x8*)(SB + (size_t)(c * 8 + h * 2 + dir) * 32768 + (32 * w + 16 * ef + fr) * 128 + 32 * dp + 8 * fq) = o; }
        }
        __syncthreads();
    }
#undef KV_ISSUE
    const h16* P = (const h16*)(p.ws + OFF_P); h16* Aconv = (h16*)(p.ws + OFF_AC) + (size_t)M * D;
    const int tq = tid >> 7, ch = (tid & 127) * 8;
    float w0[8], w1[8], w2[8];
#pragma unroll
    for (int e = 0; e < 8; ++e) { w0[e] = p.conv_w[(size_t)(l * 3 + 0) * D + ch + e]; w1[e] = p.conv_w[(size_t)(l * 3 + 1) * D + ch + e]; w2[e] = p.conv_w[(size_t)(l * 3 + 2) * D + ch + e]; }
    for (int it = (int)gridDim.x - 1 - bid; it < M / 64; it += gridDim.x) {
        const int t0 = it * 64 + 16 * tq;
        h16x8 ur[18], cbr[16];
        const h16x8 zero8 = {0, 0, 0, 0, 0, 0, 0, 0};
        ur[0] = (t0 == 0 || t0 == CTX) ? zero8 : *(const h16x8*)(P + (size_t)(t0 - 1) * PW + PC_U + ch);
#pragma unroll
        for (int k = 1; k < 17; ++k) ur[k] = *(const h16x8*)(P + (size_t)(t0 - 1 + k) * PW + PC_U + ch);
        ur[17] = (t0 + 16 == CTX || t0 + 16 == M) ? zero8 : *(const h16x8*)(P + (size_t)(t0 + 16) * PW + PC_U + ch);
#pragma unroll
        for (int k = 0; k < 16; ++k) cbr[k] = *(const h16x8*)(P + (size_t)(t0 + k) * PW + PC_CB + ch);
#pragma unroll
        for (int k = 0; k < 16; ++k) { h16x8 o;
#pragma unroll
            for (int e = 0; e < 8; ++e) o[e] = (h16)((float)cbr[k][e] * (w0[e] * (float)ur[k][e] + w1[e] * (float)ur[k + 1][e] + w2[e] * (float)ur[k + 2][e]));
            *(h16x8*)(Aconv + (size_t)(t0 + k) * D + ch) = o; }
    }
}

__device__ __forceinline__ void phase_scan(const Ctx& p, int l) {
    h16x2* SB = (h16x2*)(p.ws + OFF_RA);
    for (int g = opaque_bid() * 512 + opaque_tid(p.wv); g < 131072; g += gridDim.x * 512) {
        const int hd = g >> 14, pi = g & 16383, h = hd >> 1, dir = hd & 1;
        const float Dc = exp2f(p.rld[(l * 2 + dir) * 4 + h] * LOG2E * 128.0f);
        h16x2* base = SB + (size_t)hd * 16384 + pi;
        float r0 = 0.f, r1 = 0.f;
        for (int k0 = 0; k0 < NCH; k0 += 26) {
            h16x2 v[26];
#pragma unroll
            for (int k = 0; k < 26; ++k) { const int kk = k0 + k, idx = dir ? (kk < 2 ? 1 - kk : NCH + 1 - kk) : kk; v[k] = base[(size_t)idx * 131072]; }
#pragma unroll
            for (int k = 0; k < 26; ++k) { const int kk = k0 + k, idx = dir ? (kk < 2 ? 1 - kk : NCH + 1 - kk) : kk;
                h16x2 o; o.x = (h16)r0; o.y = (h16)r1; base[(size_t)idx * 131072] = o;
                r0 = Dc * r0 + (float)v[k].x; r1 = Dc * r1 + (float)v[k].y; }
        }
    }
}

__device__ __forceinline__ void phase_ret(const Ctx& p, int l, LAS unsigned char* lds) {
    const int tid = opaque_tid(p.wv), w = tid >> 6, lane = tid & 63, fr = lane & 15, fq = lane >> 4, bid = opaque_bid();
    LAS h16* Ks = (LAS h16*)lds; LAS h16* Ps = Ks + 128 * 136; LAS h16* Bb = Ps + 128 * 136;
    const h16* P = (const h16*)(p.ws + OFF_P); const h16* vT = (const h16*)(p.ws + OFF_VT); const h16* SB = (const h16*)(p.ws + OFF_RA);
    h16* Aret = (h16*)(p.ws + OFF_AC);
    const int u0 = (l == DEPTH - 1) ? 8 : 0;
    for (int u = bid + u0; u < NCH * 4; u += gridDim.x) {
        const int c = u >> 2, h = u & 3, row0 = c * 128, il = 16 * w + fr;
        const float lgf = p.rld[(l * 2 + 0) * 4 + h] * LOG2E, lgb = p.rld[(l * 2 + 1) * 4 + h] * LOG2E;
        h16x8 qf[4];
        { const h16* qp = P + (size_t)(row0 + il) * PW + PC_Q + h * 128 + fq * 8;
#pragma unroll
          for (int ks = 0; ks < 4; ++ks) qf[ks] = *(const h16x8*)(qp + ks * 32); }
#pragma unroll
        for (int i = 0; i < 4; ++i) { const int ch = tid + 512 * i, r = ch >> 4, cc = ch & 15;
            *(LAS u32x4*)(Ks + r * 136 + cc * 8) = *(const u32x4*)(P + (size_t)(row0 + r) * PW + PC_K + h * 128 + cc * 8); }
        u32x4 breg[4];
#define RET_LOADB(hb) do { const int _eh = (hb) & 1; const h16* _b; size_t _st; \
            if ((hb) < 2) { _b = vT + (size_t)(h * 256 + 128 * _eh) * M + row0; _st = M; } \
            else { _b = SB + (size_t)(c * 8 + h * 2 + (((hb) >> 1) - 1)) * 32768 + (size_t)(128 * _eh) * 128; _st = 128; } \
            _Pragma("unroll") for (int i = 0; i < 4; ++i) { const int ch = tid + 512 * i, r = ch >> 4, cc = ch & 15; breg[i] = *(const u32x4*)(_b + (size_t)r * _st + cc * 8); } } while (0)
        RET_LOADB(0);
        __syncthreads();
        f32x4 s[8];
#pragma unroll
        for (int n = 0; n < 8; ++n) { s[n] = (f32x4){0.f, 0.f, 0.f, 0.f};
#pragma unroll
            for (int ks = 0; ks < 4; ++ks) s[n] = MFMA16(*(const LAS h16x8*)(Ks + (16 * n + fr) * 136 + ks * 32 + fq * 8), qf[ks], s[n]); }
#pragma unroll
        for (int n = 0; n < 8; ++n) { f32x4 v;
#pragma unroll
            for (int j = 0; j < 4; ++j) { const int rel = il - (16 * n + 4 * fq + j);
                const float mk = rel > 0 ? __builtin_amdgcn_exp2f(lgf * (float)rel) : (rel < 0 ? __builtin_amdgcn_exp2f(lgb * (float)(-rel)) : 2.0f);
                v[j] = s[n][j] * mk; }
            *(LAS h16x4*)(Ps + il * 136 + 16 * n + 4 * fq) = cvt4(v); }
        const h16 wqf = (h16)exp2f(lgf * (float)(il + 1)), wqb = (h16)exp2f(lgb * (float)(128 - il));
        f32x4 o[16];
#pragma unroll
        for (int n = 0; n < 16; ++n) o[n] = (f32x4){0.f, 0.f, 0.f, 0.f};
#pragma unroll 1
        for (int hp = 0; hp < 3; ++hp) {
            h16x8 af[4];
            if (hp == 0) {
#pragma unroll
                for (int ks = 0; ks < 4; ++ks) af[ks] = *(const LAS h16x8*)(Ps + il * 136 + ks * 32 + fq * 8);
            } else { const h16 wq = hp == 1 ? wqf : wqb;
#pragma unroll
                for (int ks = 0; ks < 4; ++ks) af[ks] = qf[ks] * wq; }
#pragma unroll
            for (int eh = 0; eh < 2; ++eh) {
                const int hb = hp * 2 + eh;
                LAS h16* B = Bb + eh * (128 * 136);
#pragma unroll
                for (int i = 0; i < 4; ++i) { const int ch = tid + 512 * i, r = ch >> 4, cc = ch & 15; *(LAS u32x4*)(B + ((r & ~31) + slot32(r & 31)) * 136 + cc * 8) = breg[i]; }
                if (hb < 5) RET_LOADB(hb + 1);
                __syncthreads();
#pragma unroll
                for (int nf = 0; nf < 8; ++nf)
#pragma unroll
                    for (int ks = 0; ks < 4; ++ks) o[eh * 8 + nf] = MFMA16(*(const LAS h16x8*)(B + (16 * nf + fr) * 136 + ks * 32 + fq * 8), af[ks], o[eh * 8 + nf]);
            }
        }
        const h16* gp = P + (size_t)(row0 + il) * PW + PC_G + h * 256 + 8 * fq;
        h16x8 gq[8];
#pragma unroll
        for (int np = 0; np < 8; ++np) gq[np] = *(const h16x8*)(gp + 32 * np);
        __builtin_amdgcn_sched_barrier(0);
        float ss = 0.f;
#pragma unroll
        for (int n = 0; n < 16; ++n) ss += o[n].x * o[n].x + o[n].y * o[n].y + o[n].z * o[n].z + o[n].w * o[n].w;
        ss += __shfl_xor(ss, 16); ss += __shfl_xor(ss, 32);
        const float rs = __builtin_amdgcn_rsqf(ss * (1.0f / 256.0f) + NEPS);
        h16* op = Aret + (size_t)(row0 + il) * D + h * 256 + 8 * fq;
#pragma unroll
        for (int np = 0; np < 8; ++np) { const h16x8 g = gq[np]; h16x8 v;
#pragma unroll
            for (int j = 0; j < 4; ++j) { v[j] = (h16)(silu((float)g[j]) * o[2 * np][j] * rs); v[4 + j] = (h16)(silu((float)g[4 + j]) * o[2 * np + 1][j] * rs); }
            *(h16x8*)(op + 32 * np) = v; }
        __syncthreads();
    }
}

#define XB_TMO      128
#define XB_XCNT(j)  (256  + 64 * (j))
#define XB_XSUB(j)  (1280 + 64 * (j))
#define XB_XGEN(j)  (2304 + 64 * (j))
#define XB_TOP      3328
#define XB_TOPGEN   3392
#define XB_WORDS    3456
#define XB_SPIN_CAP (1u << 20)
__device__ __forceinline__ unsigned xb_ld(unsigned* p) { return __hip_atomic_load(p, __ATOMIC_RELAXED, __HIP_MEMORY_SCOPE_AGENT); }
__device__ __forceinline__ unsigned xb_add(unsigned* p, unsigned v) { return __hip_atomic_fetch_add(p, v, __ATOMIC_RELAXED, __HIP_MEMORY_SCOPE_AGENT); }
__device__ __forceinline__ unsigned xb_xcc_id() { return (unsigned)__builtin_amdgcn_s_getreg((3 << 11) | 20) & 0xFu; }
#define XB_SPIN(cond, bar) do { unsigned _sp = 0; while (cond) { __builtin_amdgcn_s_sleep(1); \
    if ((++_sp & 255u) == 0u) { if (xb_ld(&(bar)[XB_TMO])) break; if (_sp > XB_SPIN_CAP) { atomicAdd(&(bar)[XB_TMO], 1u); break; } } } } while (0)
__device__ __forceinline__ void grid_barrier(unsigned* bar, volatile LAS unsigned* st, int wv) {
    asm volatile("s_waitcnt vmcnt(0)" ::: "memory");
    __syncthreads();
    if (opaque_tid(wv) == 0) {
        __builtin_amdgcn_s_waitcnt(0);
        const unsigned x = xb_xcc_id();
        unsigned nloc = st[0], nx = st[1];
        if (nloc == 0u) {
            const unsigned G = gridDim.x; unsigned sum, cnt, mine, sp = 0u;
            for (;;) { sum = 0u; cnt = 0u; mine = 0u;
#pragma unroll
                for (unsigned j = 0; j < 16; ++j) { const unsigned c = xb_ld(&bar[XB_XCNT(j)]); sum += c; cnt += (c > 0u) ? 1u : 0u; mine = (j == x) ? c : mine; }
                if (sum == G) break;
                __builtin_amdgcn_s_sleep(1);
                if ((++sp & 255u) == 0u) { if (xb_ld(&bar[XB_TMO])) break; if (sp > XB_SPIN_CAP) { atomicAdd(&bar[XB_TMO], 1u); break; } } }
            nloc = mine > 0u ? mine : 1u; nx = cnt > 0u ? cnt : 1u; st[0] = nloc; st[1] = nx; }
        const unsigned old = xb_add(&bar[XB_XSUB(x)], 1u);
        const unsigned gen = old / nloc;
        if (old + 1u == (gen + 1u) * nloc) {
            __builtin_amdgcn_fence(__ATOMIC_RELEASE, "agent");
            asm volatile("s_waitcnt vmcnt(0)" ::: "memory");
            const unsigned og = xb_add(&bar[XB_TOP], 1u);
            const unsigned tg = og / nx;
            if (og + 1u == (tg + 1u) * nx) xb_add(&bar[XB_TOPGEN], 1u);
            else XB_SPIN(xb_ld(&bar[XB_TOPGEN]) == tg, bar);
            __builtin_amdgcn_fence(__ATOMIC_ACQUIRE, "agent");
            xb_add(&bar[XB_XGEN(x)], 1u);
            asm volatile("s_waitcnt vmcnt(0)" ::: "memory");
        } else {
            XB_SPIN(xb_ld(&bar[XB_XGEN(x)]) == gen, bar);
            __builtin_amdgcn_fence(__ATOMIC_ACQUIRE, "agent");
            asm volatile("s_waitcnt vmcnt(0)" ::: "memory");
        }
    }
    __syncthreads();
}
__global__ void __launch_bounds__(512, 2) fwd_megakernel(Params p0) {
    extern __shared__ __attribute__((aligned(16))) unsigned char smem[];
    LAS unsigned char* lds = (LAS unsigned char*)smem;
    Ctx p; *(Params*)&p = p0; p.wv = __builtin_amdgcn_readfirstlane(threadIdx.x >> 6);
    if (p.ph_hi < 0) cg::this_grid().sync();
    unsigned* bar = (unsigned*)(p.ws + OFF_BAR);
    volatile LAS unsigned* st = (volatile LAS unsigned*)(lds + LDS_BYTES - 16);
    if (threadIdx.x == 0) { st[0] = 0u; st[1] = 0u; (void)xb_add(&bar[XB_XCNT(xb_xcc_id())], 1u); }
    __syncthreads();
    int ph = 0;
#define DUPP(bit, ...) do { __VA_ARGS__; if (DUP_MASK & (bit)) { __VA_ARGS__; } } while (0)
#define PHASE(...) do { if (ph >= p.ph_lo && ph < p.ph_hi) { if (ph > p.ph_lo) grid_barrier(bar, st, p.wv); __VA_ARGS__; } ++ph; } while (0)
    const char* ws = (const char*)p.ws;
    const float* mod = (const float*)(p.ws + OFF_MOD);
    const float* cosT = (const float*)(p.ws + OFF_ROPE); const float* sinT = cosT + 256 * 32;
    PHASE({ phase_setup(p, lds); phase_cvt(p, 0, lds, 0); });
#pragma unroll 1
    for (int l = 0; l < DEPTH; ++l) {
        const float* ml = mod + (size_t)(l * 2) * 9216; const float* mc = ml + 9216;
        const h16* Wt = (const h16*)(p.ws + OFF_W) + (size_t)(l & 1) * W_END;
        PHASE(phase_norm(p, l, 0, l ? 11 : 0, l == 0));
#pragma unroll 1
        for (int f = 0; f < 2; ++f) {
            if (f == 1) {
                PHASE(DUPP(2, phase_norm(p, l, 1, 11)));
                PHASE({ Pol<G_INP> S{}; S.A = ws + OFF_Y; S.B = (const char*)(Wt + W_N); S.A2 = (const char*)(Wt + W_KV); S.nM = 65; S.nN = 34; S.K = D;
                        S.O = (h16*)(p.ws + OFF_P); S.O2 = (h16*)(p.ws + OFF_RA + SZ_SB); S.O3 = (h16*)(p.ws + OFF_VT); S.cosT = cosT; S.sinT = sinT; DUPP(32, gemm_phase(lds, S, p.wv)); });
                PHASE(DUPP(4, phase_kv(p, l, lds)));
                PHASE(phase_scan(p, l));
                PHASE(DUPP(8, phase_ret(p, l, lds)));
                PHASE({ Pol<G_YG> S{}; S.A = ws + OFF_AC; S.B = (const char*)(Wt + W_RO); S.A2 = ws + OFF_AC + (size_t)M * D * 2; S.B2 = (const char*)(Wt + W_CO); S.nM = 65; S.nN = 4; S.K = D;
                        S.O = (h16*)(p.ws + OFF_Y); S.P = (const h16*)(p.ws + OFF_P);
                        const bool cvt_first = (l + 1 < DEPTH) && (blockIdx.x & 1);
                        if (cvt_first) { phase_cvt(p, l + 1, lds, gridDim.x > 16 ? 8 : 0); __syncthreads(); }
                        DUPP(64, gemm_phase(lds, S, p.wv));
                        if (l + 1 < DEPTH) { Pol<G_YGC> C{}; C.A = S.A; C.B = S.B; C.A2 = S.A2; C.B2 = S.B2; C.K = D; C.O2 = (h16*)(p.ws + OFF_MGC); C.O3 = (h16*)(p.ws + OFF_MGC) + (size_t)CTX * D; C.P = S.P; gemm_phase(lds, C, p.wv); }
                        if (l + 1 < DEPTH && !cvt_first) phase_cvt(p, l + 1, lds, gridDim.x > 16 ? 8 : 0); });
                PHASE({ Pol<G_OUT> S{}; S.A = ws + OFF_Y; S.B = (const char*)(Wt + W_O); S.A2 = ws + OFF_MGC; S.B2 = ws + OFF_MGC + (size_t)CTX * D * 2; S.nM = 65; S.nN = 4; S.K = D; S.noctx = (l == DEPTH - 1);
                        S.X = (h16*)(p.ws + OFF_X); S.gate_lat = ml + 5 * D; S.gate_ctx = mc + 5 * D; S.gs = 1.0f; S.PART = (float*)(p.ws + OFF_PART); gemm_phase(lds, S, p.wv); });
                PHASE(DUPP(2, phase_norm(p, l, 2, l + 1 < DEPTH ? 8 : 0)));
            }
            PHASE({ Pol<G_UP> S{}; S.A = ws + OFF_Y; S.B = (const char*)(Wt + (f ? W_UP2 : W_UP1)); S.nM = 65; S.nN = 22; S.K = D; S.O = (h16*)(p.ws + OFF_RA); DUPP(16, gemm_phase(lds, S, p.wv)); });
            PHASE({ Pol<G_DN> S{}; S.A = ws + OFF_RA; S.B = (const char*)(Wt + (f ? W_DN2 : W_DN1)); S.nM = 65; S.nN = 4; S.K = DFF; S.noctx = (f == 1 && l == DEPTH - 1);
                    S.X = (h16*)(p.ws + OFF_X); S.gate_lat = ml + (f ? 8 : 2) * D; S.gate_ctx = mc + (f ? 8 : 2) * D; S.gs = 0.5f; S.PART = (float*)(p.ws + OFF_PART); gemm_phase(lds, S, p.wv); });
        }
    }
    PHASE(phase_final(p));
}
constexpr int N_PHASES = 1 + DEPTH * 13 + 1;

extern "C" void kernel_launch(void* const* d_in, const int* in_sizes, int n_in, void* d_out, int out_size, void* d_ws, size_t ws_size, hipStream_t stream) {
    static int grid_blocks = 0;
    if (grid_blocks == 0) {
        if (n_in != 18 || out_size != SEQ * D || ws_size < WS_END) { fprintf(stderr, "kernel_launch: unexpected shapes / workspace (%d inputs, out %d, ws %zu, need %zu)\n", n_in, out_size, ws_size, (size_t)WS_END); grid_blocks = -1; return; }
        if (hipFuncSetAttribute((const void*)fwd_megakernel, hipFuncAttributeMaxDynamicSharedMemorySize, LDS_BYTES) != hipSuccess) { fprintf(stderr, "kernel_launch: hipFuncSetAttribute failed\n"); grid_blocks = -1; return; }
        int dev = 0, cus = 0, per_cu = 0;
        hipGetDevice(&dev);
        hipDeviceGetAttribute(&cus, hipDeviceAttributeMultiprocessorCount, dev);
        hipOccupancyMaxActiveBlocksPerMultiprocessor(&per_cu, (const void*)fwd_megakernel, 512, LDS_BYTES);
        if (per_cu < 1) { fprintf(stderr, "kernel_launch: occupancy query says %d blocks per CU\n", per_cu); per_cu = 1; }
        (void)hipGetLastError();
        grid_blocks = cus;
    }
    if (grid_blocks < 0) return;
    Params p{};
    p.x = (const float*)d_in[0]; p.c = (const float*)d_in[1]; p.ctx = (const float*)d_in[2]; p.c_ctx = (const float*)d_in[3]; p.norm_w = (const float*)d_in[4];
    p.w_mod = (const float*)d_in[5]; p.b_mod = (const float*)d_in[6]; p.f1u = (const float*)d_in[7]; p.f1d = (const float*)d_in[8]; p.w_in = (const float*)d_in[9];
    p.rld = (const float*)d_in[10]; p.conv_w = (const float*)d_in[11]; p.wro = (const float*)d_in[12]; p.wco = (const float*)d_in[13]; p.wo = (const float*)d_in[14];
    p.f2u = (const float*)d_in[15]; p.f2d = (const float*)d_in[16]; p.fnw = (const float*)d_in[17];
    p.out = (float*)d_out; p.ws = (unsigned char*)d_ws;
#if N_SPLIT
    for (int ph = 0; ph < N_PHASES; ++ph) { p.ph_lo = ph; p.ph_hi = ph + 1; hipLaunchKernelGGL(fwd_megakernel, dim3(grid_blocks), dim3(512), LDS_BYTES, stream, p); }
#else
    p.ph_lo = 0; p.ph_hi = N_PHASES;
    (void)hipMemsetAsync((char*)d_ws + OFF_BAR, 0, 16384, stream);
    void* args[] = {&p};
    hipError_t e = hipLaunchCooperativeKernel((const void*)fwd_megakernel, dim3(grid_blocks), dim3(512), args, LDS_BYTES, stream);
    if (e != hipSuccess) fprintf(stderr, "cooperative launch failed: %s (grid %d)\n", hipGetErrorString(e), grid_blocks);
#endif
}
```

```cpp
#include <hip/hip_runtime.h>
#include <hip/hip_cooperative_groups.h>
#include <cstdio>
namespace cg = cooperative_groups;

#define LAS __attribute__((address_space(3)))
typedef _Float16 h16;
typedef _Float16 h16x8 __attribute__((ext_vector_type(8)));
typedef _Float16 h16x4 __attribute__((ext_vector_type(4)));
typedef _Float16 h16x2 __attribute__((ext_vector_type(2)));
typedef float f32x4 __attribute__((ext_vector_type(4)));
typedef unsigned u32x4 __attribute__((ext_vector_type(4)));

#ifndef DUP_MASK
#define DUP_MASK 0
#endif
#ifndef N_SPLIT
#define N_SPLIT 0
#endif

constexpr int D = 1024, SEQ = 16384, CTX = 256, M = SEQ + CTX, DEPTH = 4, DFF = 2816, NUP = 5632;
constexpr int NCH = M / 128;
constexpr int PW = 6144, WNR = 7168;
constexpr int PC_K = 0, PC_Q = 512, PC_G = 1024, PC_CB = 2048, PC_U = 3072, PC_GR = 4096, PC_GC = 5120;
constexpr float LOG2E = 1.4426950408889634f;
constexpr float NEPS = 1e-6f;

constexpr size_t SZ_X = (size_t)M * D * 2;
constexpr size_t SZ_Y = (size_t)M * D * 2;
constexpr size_t SZ_H = (size_t)M * DFF * 2;
constexpr size_t SZ_SB = (size_t)NCH * 8 * 32768 * 2;
constexpr size_t SZ_KT = (size_t)512 * M * 2;
constexpr size_t SZ_P = (size_t)M * PW * 2;
constexpr size_t SZ_VT = (size_t)1024 * M * 2;
constexpr size_t SZ_AC = (size_t)M * 2048 * 2;
static_assert(SZ_SB + SZ_KT <= SZ_H, "alias");
constexpr size_t OFF_X = 0;
constexpr size_t OFF_Y = OFF_X + SZ_X;
constexpr size_t OFF_RA = OFF_Y + SZ_Y;
constexpr size_t OFF_P = OFF_RA + SZ_H;
constexpr size_t OFF_VT = OFF_P + SZ_P;
constexpr size_t OFF_AC = OFF_VT + SZ_VT;
constexpr size_t OFF_W = OFF_AC + SZ_AC;
constexpr size_t W_UP1 = 0, W_DN1 = W_UP1 + (size_t)NUP * D, W_KV = W_DN1 + (size_t)D * DFF, W_N = W_KV + (size_t)1536 * D,
                 W_RO = W_N + (size_t)WNR * D, W_CO = W_RO + (size_t)D * D, W_O = W_CO + (size_t)D * D, W_UP2 = W_O + (size_t)D * D,
                 W_DN2 = W_UP2 + (size_t)NUP * D, W_END = W_DN2 + (size_t)D * DFF;
constexpr size_t OFF_MOD = OFF_W + 2 * W_END * 2;
constexpr size_t OFF_ROPE = OFF_MOD + (size_t)4 * 2 * 9216 * 4;
constexpr size_t OFF_BAR = OFF_ROPE + (size_t)256 * 32 * 2 * 4;
constexpr size_t OFF_PART = OFF_BAR + 16384;
constexpr size_t OFF_MGC = OFF_PART + (size_t)11 * CTX * D * 4;
constexpr size_t WS_END = OFF_MGC + (size_t)2 * CTX * D * 2;
constexpr int LDS_BYTES = 147456;

struct Params {
    const float* x; const float* c; const float* ctx; const float* c_ctx; const float* norm_w; const float* w_mod; const float* b_mod;
    const float* f1u; const float* f1d; const float* w_in; const float* rld; const float* conv_w; const float* wro; const float* wco; const float* wo;
    const float* f2u; const float* f2d; const float* fnw;
    float* out; unsigned char* ws; int ph_lo, ph_hi;
};
struct Ctx : Params { int wv; };

__device__ __forceinline__ int opaque_tid(int wv) { asm volatile("" : "+s"(wv)); int t = wv * 64 + (int)__builtin_amdgcn_mbcnt_hi(~0u, __builtin_amdgcn_mbcnt_lo(~0u, 0u)); asm volatile("" : "+v"(t)); return t; }
__device__ __forceinline__ int opaque_bid() { int b = blockIdx.x; asm volatile("" : "+s"(b)); return b; }
__device__ __forceinline__ float wave_sum(float v) {
#pragma unroll
    for (int o = 1; o < 64; o <<= 1) v += __shfl_xor(v, o);
    return v;
}
__device__ __forceinline__ float sigm(float x) { return __builtin_amdgcn_rcpf(1.0f + __builtin_amdgcn_exp2f(-x * LOG2E)); }
__device__ __forceinline__ float silu(float x) { return x * sigm(x); }
__device__ __forceinline__ h16x4 cvt4(f32x4 v) { h16x4 o; o.x = (h16)v.x; o.y = (h16)v.y; o.z = (h16)v.z; o.w = (h16)v.w; return o; }

constexpr int BM = 256, BK = 64, HALF = 128, HTB = HALF * BK * 2;
__device__ __forceinline__ int lds_byte(int r, int c) { const int st = (r >> 4) * 2 + (c >> 5), rr = r & 15, cc = c & 31, ob = rr * 64 + cc * 2; return st * 1024 + (ob ^ (((ob >> 9) & 1) << 5)); }
__device__ __forceinline__ void stage_rc(int b, int& R, int& C) { const int st = b / 1024, sb = b % 1024, swz = sb ^ (((sb >> 9) & 1) << 5); R = (st >> 1) * 16 + swz / 64; C = (st & 1) * 32 + (swz % 64) / 2; }
__device__ __forceinline__ void tile_of(int L, int nM, int nN, int& pm, int& pn) {
    const int nwg = nM * nN; int wgid = L;
    { const int q = nwg / 8, r = nwg % 8, xcd = wgid % 8, off = wgid / 8; wgid = (xcd < r ? xcd * (q + 1) : r * (q + 1) + (xcd - r) * q) + off; }
    const int nig = 8 * nN, gid = wgid / nig, fm = gid * 8, gsz = (nM - fm) < 8 ? (nM - fm) : 8;
    pm = __builtin_amdgcn_readfirstlane(fm + ((wgid % nig) % gsz)); pn = __builtin_amdgcn_readfirstlane((wgid % nig) / gsz);
}

struct Unit { const char* A; const char* B; int pm, pn, part, nt; };
typedef f32x4 Acc[2][2][4][2];

enum { G_UP = 0, G_DN = 1, G_INP = 2, G_YG = 3, G_OUT = 4, G_YGC = 5 };

template <int KIND> struct Pol {
    const char* A; const char* B; const char* A2; const char* B2;
    int nM, nN, K, noctx;
    h16* X; const float* gate_lat; const float* gate_ctx; float gs;
    h16* O; h16* O2; h16* O3; const h16* P; const float* cosT; const float* sinT; float* PART;

    __device__ __forceinline__ bool next(int i, Unit& u, int bid) const {
        const int G = gridDim.x, c = bid;
        int L = i * G + c, part = 0;
        const size_t tstep = (size_t)BM * K * 2;
        u.nt = K / BK;
        if (KIND == G_YG) {
            const int Lp = (i >> 1) * G + c; if (Lp >= 256) return false;
            int pm, pn; tile_of(Lp, 64, 4, pm, pn); part = i & 1;
            u.pm = pm + 1; u.pn = pn; u.part = part; u.A = (part ? A2 : A) + (size_t)(pm + 1) * tstep; u.B = (part ? B2 : B) + (size_t)pn * tstep; return true;
        }
        if (KIND == G_YGC) {
            if (L >= 8) return false;
            part = L >> 2; u.pm = 0; u.pn = L & 3; u.part = 2 + part; u.A = part ? A2 : A; u.B = (part ? B2 : B) + (size_t)(L & 3) * tstep; return true;
        }
        if (KIND == G_DN || KIND == G_OUT) {
            const int nlat = 64 * 4, nsl = noctx ? 0 : ((KIND == G_OUT) ? 8 : K / 256);
            if (L >= nlat + 4 * nsl) return false;
            if (L >= nlat) { const int idx = L - nlat, pn = idx & 3, sl = idx >> 2;
                u.pm = 0; u.pn = pn; u.part = 1 + sl; u.nt = 4;
                if (KIND == G_OUT) { u.A = ((sl >> 2) ? B2 : A2) + (size_t)(sl & 3) * 512; u.B = B + (size_t)pn * tstep + (size_t)(sl & 3) * 512; }
                else { u.A = A + (size_t)sl * 512; u.B = B + (size_t)pn * tstep + (size_t)sl * 512; }
                return true; }
            int pm, pn; tile_of(L, 64, 4, pm, pn);
            u.pm = pm + 1; u.pn = pn; u.part = 0; u.A = A + (size_t)(pm + 1) * tstep; u.B = B + (size_t)pn * tstep; return true;
        }
        if (L >= nM * nN) return false;
        int pm, pn; tile_of(L, nM, nN, pm, pn);
        u.pm = pm; u.pn = pn; u.part = part;
        if (KIND == G_INP && pn >= 28) { u.A = A2 + (size_t)(pn - 28) * tstep; u.B = A + (size_t)pm * tstep; }
        else { u.A = A + (size_t)pm * tstep; u.B = B + (size_t)pn * tstep; }
        return true;
    }
    __device__ __forceinline__ bool keep(const Unit& u) const { return KIND == G_YG && u.part == 0; }

    __device__ __forceinline__ void epi(Acc& acc, const Unit& u, int wr, int wc, int fr, int fq) const {
        const int r0 = u.pm * BM + wr * 64 + fr;
        if (KIND == G_UP) {
            const int hc0 = u.pn * 128 + 32 * wc + 8 * fq;
#pragma unroll
            for (int ai = 0; ai < 2; ++ai)
#pragma unroll
                for (int m = 0; m < 4; ++m) { h16x8 o;
#pragma unroll
                    for (int n = 0; n < 2; ++n) { const f32x4 a = acc[ai][0][m][n], b = acc[ai][1][m][n];
#pragma unroll
                        for (int j = 0; j < 4; ++j) o[4 * n + j] = (h16)(silu(a[j]) * b[j]); }
                    *(h16x8*)(O + (size_t)(r0 + ai * HALF + m * 16) * DFF + hc0) = o; }
        } else if (KIND == G_DN || KIND == G_OUT) {
            const int c0 = u.pn * BM + wc * 32 + 8 * fq;
            const float* gate = (u.pm == 0) ? gate_ctx : gate_lat;
            f32x4 g[2][2];
#pragma unroll
            for (int bj = 0; bj < 2; ++bj)
#pragma unroll
                for (int n = 0; n < 2; ++n) g[bj][n] = *(const f32x4*)(gate + c0 + bj * HALF + n * 4) * gs;
            if (u.part) {
#pragma unroll
                for (int ai = 0; ai < 2; ++ai)
#pragma unroll
                    for (int m = 0; m < 4; ++m)
#pragma unroll
                        for (int bj = 0; bj < 2; ++bj)
#pragma unroll
                            for (int n = 0; n < 2; ++n)
                                *(f32x4*)(PART + (size_t)(u.part - 1) * CTX * D + (size_t)(r0 + ai * HALF + m * 16) * D + c0 + bj * HALF + n * 4) = g[bj][n] * acc[ai][bj][m][n];
            } else {
                h16x8 xv[2][4][2];
#pragma unroll
                for (int ai = 0; ai < 2; ++ai)
#pragma unroll
                    for (int m = 0; m < 4; ++m)
#pragma unroll
                        for (int bj = 0; bj < 2; ++bj) xv[ai][m][bj] = *(const h16x8*)(X + (size_t)(r0 + ai * HALF + m * 16) * D + c0 + bj * HALF);
#pragma unroll
                for (int ai = 0; ai < 2; ++ai)
#pragma unroll
                    for (int m = 0; m < 4; ++m)
#pragma unroll
                        for (int bj = 0; bj < 2; ++bj) { const h16x8 x = xv[ai][m][bj]; h16x8 o;
#pragma unroll
                            for (int j = 0; j < 4; ++j) { o[j] = (h16)((float)x[j] + g[bj][0][j] * acc[ai][bj][m][0][j]); o[4 + j] = (h16)((float)x[4 + j] + g[bj][1][j] * acc[ai][bj][m][1][j]); }
                            *(h16x8*)(X + (size_t)(r0 + ai * HALF + m * 16) * D + c0 + bj * HALF) = o; }
            }
        } else if (KIND == G_INP) {
            if (u.pn >= 28) {
                const int ft = u.pn - 28;
                const int t0 = u.pm * BM + wc * 32 + 4 * fq;
                if (ft < 2) {
                    const float ks = 0.08838834764831845f;
#pragma unroll
                    for (int bj = 0; bj < 2; ++bj) { f32x4 csk[2][2], snk[2][2];
#pragma unroll
                        for (int n = 0; n < 2; ++n)
#pragma unroll
                            for (int m = 0; m < 2; ++m) { csk[n][m] = (f32x4){1.f, 1.f, 1.f, 1.f}; snk[n][m] = (f32x4){0.f, 0.f, 0.f, 0.f};
                                if (u.pm > 0) { const int f = 16 * m + fr, nt = t0 + bj * HALF + n * 16 - CTX;
#pragma unroll
                                    for (int j = 0; j < 4; ++j) { const int pos = wr ? ((nt + j) & 63) : ((nt + j) >> 6); csk[n][m][j] = cosT[pos * 32 + f]; snk[n][m][j] = sinT[pos * 32 + f]; } } }
                        __builtin_amdgcn_sched_barrier(0);
#pragma unroll
                        for (int ai = 0; ai < 2; ++ai)
#pragma unroll
                            for (int n = 0; n < 2; ++n) { const int t = t0 + bj * HALF + n * 16;
#pragma unroll
                                for (int m = 0; m < 2; ++m) { const f32x4 a0 = acc[ai][bj][m][n] * ks, b0 = acc[ai][bj][m + 2][n] * ks;
                                    const f32x4 a = a0 * csk[n][m] - b0 * snk[n][m], b = a0 * snk[n][m] + b0 * csk[n][m];
                                    const int F = ft * 256 + ai * HALF + wr * 64 + 16 * m + fr;
                                    *(h16x4*)(O2 + (size_t)F * M + t) = cvt4(a); *(h16x4*)(O2 + (size_t)(F + 32) * M + t) = cvt4(b); } }
                        __builtin_amdgcn_sched_barrier(0); }
                } else {
#pragma unroll
                    for (int ai = 0; ai < 2; ++ai)
#pragma unroll
                        for (int m = 0; m < 4; ++m) { h16* rowp = O3 + (size_t)((ft - 2) * 256 + ai * HALF + wr * 64 + 16 * m + fr) * M + t0;
#pragma unroll
                            for (int bj = 0; bj < 2; ++bj)
#pragma unroll
                                for (int n = 0; n < 2; ++n) *(h16x4*)(rowp + bj * HALF + n * 16) = cvt4(acc[ai][bj][m][n]); }
                }
            } else if (u.pn < 4) {
                const float sc = (u.pn < 2) ? 0.08838834764831845f : 1.0f;
                const int phi0 = 64 * (wc >> 1) + 16 * (wc & 1) + 4 * fq, f0 = 16 * (wc & 1) + 4 * fq;
                const int cb = (u.pn < 2 ? PC_K : PC_Q) + (u.pn & 1) * 256 + phi0;
#pragma unroll
                for (int ai = 0; ai < 2; ++ai) { f32x4 csv[4], snv[4];
#pragma unroll
                    for (int m = 0; m < 4; ++m) { const int row = r0 + ai * HALF + m * 16; csv[m] = (f32x4){1.f, 1.f, 1.f, 1.f}; snv[m] = (f32x4){0.f, 0.f, 0.f, 0.f};
                        if (u.pm > 0) { const int nt = row - CTX, pos = (wc >> 1) ? (nt & 63) : (nt >> 6); csv[m] = *(const f32x4*)(cosT + pos * 32 + f0); snv[m] = *(const f32x4*)(sinT + pos * 32 + f0); } }
                    __builtin_amdgcn_sched_barrier(0);
#pragma unroll
                    for (int m = 0; m < 4; ++m) { const int row = r0 + ai * HALF + m * 16; const f32x4 cs = csv[m], sn = snv[m];
#pragma unroll
                        for (int bj = 0; bj < 2; ++bj) { const f32x4 a = acc[ai][bj][m][0] * sc, b = acc[ai][bj][m][1] * sc;
                            h16* op = O + (size_t)row * PW + cb + bj * HALF;
                            *(h16x4*)op = cvt4(a * cs - b * sn); *(h16x4*)(op + 32) = cvt4(a * sn + b * cs); } }
                    __builtin_amdgcn_sched_barrier(0); }
            } else if (u.pn >= 12 && u.pn < 20) {
                const int c0 = PC_U + (u.pn - 12) * 128 + wc * 32 + 8 * fq;
#pragma unroll
                for (int ai = 0; ai < 2; ++ai)
#pragma unroll
                    for (int m = 0; m < 4; ++m) { h16x8 o;
#pragma unroll
                        for (int j = 0; j < 4; ++j) { o[j] = (h16)(acc[ai][0][m][0][j] * acc[ai][1][m][0][j]); o[4 + j] = (h16)(acc[ai][0][m][1][j] * acc[ai][1][m][1][j]); }
                        *(h16x8*)(O + (size_t)(r0 + ai * HALF + m * 16) * PW + c0) = o; }
            } else {
                const int c0 = (u.pn < 12 ? u.pn * BM : PC_GR + (u.pn - 20) * BM) + wc * 32 + 8 * fq;
#pragma unroll
                for (int ai = 0; ai < 2; ++ai)
#pragma unroll
                    for (int m = 0; m < 4; ++m) { h16* rowp = O + (size_t)(r0 + ai * HALF + m * 16) * PW + c0;
#pragma unroll
                        for (int bj = 0; bj < 2; ++bj) { h16x8 o;
#pragma unroll
                            for (int j = 0; j < 4; ++j) { o[j] = (h16)acc[ai][bj][m][0][j]; o[4 + j] = (h16)acc[ai][bj][m][1][j]; }
                            *(h16x8*)(rowp + bj * HALF) = o; } }
            }
        } else if (KIND == G_YGC) {
            const int c0 = u.pn * BM + wc * 32 + 8 * fq;
            const h16* gp = P + (u.part == 2 ? PC_GR : PC_GC) + c0; h16* op = (u.part == 2 ? O2 : O3) + c0;
#pragma unroll
            for (int ai = 0; ai < 2; ++ai) { h16x8 gv[4][2];
#pragma unroll
                for (int m = 0; m < 4; ++m)
#pragma unroll
                    for (int bj = 0; bj < 2; ++bj) gv[m][bj] = *(const h16x8*)(gp + (size_t)(r0 + ai * HALF + m * 16) * PW + bj * HALF);
                __builtin_amdgcn_sched_barrier(0);
#pragma unroll
                for (int m = 0; m < 4; ++m) { const size_t row = (size_t)(r0 + ai * HALF + m * 16);
#pragma unroll
                    for (int bj = 0; bj < 2; ++bj) { const h16x8 g = gv[m][bj]; h16x8 o;
#pragma unroll
                        for (int n = 0; n < 2; ++n)
#pragma unroll
                            for (int j = 0; j < 4; ++j) o[4 * n + j] = (h16)(acc[ai][bj][m][n][j] * sigm(fmaxf((float)g[4 * n + j], -30.f)));
                        *(h16x8*)(op + row * D + bj * HALF) = o; } }
                __builtin_amdgcn_sched_barrier(0); }
        } else if (KIND == G_YG) {
            const int c0 = u.pn * BM + wc * 32 + 8 * fq;
            if (u.part == 0) {
#pragma unroll
                for (int ai = 0; ai < 2; ++ai) { h16x8 gr[4][2], gc[4][2];
#pragma unroll
                    for (int m = 0; m < 4; ++m)
#pragma unroll
                        for (int bj = 0; bj < 2; ++bj) { const h16* gp = P + (size_t)(r0 + ai * HALF + m * 16) * PW + c0 + bj * HALF;
                            gr[m][bj] = *(const h16x8*)(gp + PC_GR); gc[m][bj] = *(const h16x8*)(gp + PC_GC); }
                    __builtin_amdgcn_sched_barrier(0);
#pragma unroll
                    for (int m = 0; m < 4; ++m)
#pragma unroll
                        for (int bj = 0; bj < 2; ++bj)
#pragma unroll
                            for (int n = 0; n < 2; ++n) { f32x4 q;
#pragma unroll
                                for (int j = 0; j < 4; ++j) { const float er = __builtin_amdgcn_exp2f(-fmaxf((float)gr[m][bj][4 * n + j], -30.f) * LOG2E), ec = __builtin_amdgcn_exp2f(-fmaxf((float)gc[m][bj][4 * n + j], -30.f) * LOG2E);
                                    q[j] = (1.0f + ec) * __builtin_amdgcn_rcpf(1.0f + er); }
                                acc[ai][bj][m][n] = acc[ai][bj][m][n] * q; } }
            } else {
#pragma unroll
                for (int ai = 0; ai < 2; ++ai) { h16x8 gv[4][2];
#pragma unroll
                    for (int m = 0; m < 4; ++m)
#pragma unroll
                        for (int bj = 0; bj < 2; ++bj) gv[m][bj] = *(const h16x8*)(P + (size_t)(r0 + ai * HALF + m * 16) * PW + PC_GC + c0 + bj * HALF);
                    __builtin_amdgcn_sched_barrier(0);
#pragma unroll
                    for (int m = 0; m < 4; ++m) { const size_t row = (size_t)(r0 + ai * HALF + m * 16);
#pragma unroll
                        for (int bj = 0; bj < 2; ++bj) { const h16x8 gc = gv[m][bj]; h16x8 o;
#pragma unroll
                            for (int n = 0; n < 2; ++n)
#pragma unroll
                                for (int j = 0; j < 4; ++j) o[4 * n + j] = (h16)(acc[ai][bj][m][n][j] * sigm(fmaxf((float)gc[4 * n + j], -30.f)));
                            *(h16x8*)(O + row * D + c0 + bj * HALF) = o; } }
                    __builtin_amdgcn_sched_barrier(0); }
            }
        }
    }
};

template <class P_> __device__ __forceinline__ void gemm_phase(LAS unsigned char* lds, const P_& S, int wv_) {
    const int tid = opaque_tid(wv_), wid = __builtin_amdgcn_readfirstlane(tid >> 6), lane = tid & 63, wr = wid >> 2, wc = wid & 3, fr = lane & 15, fq = lane >> 4;
    const int K = S.K;
    unsigned voff[2];
#pragma unroll
    for (int i = 0; i < 2; ++i) { int R, C; stage_rc(tid * 16 + i * 8192, R, C); voff[i] = (unsigned)(R * K + C) * 2u; }
    const size_t kstep = (size_t)(BK * 2), hstep = (size_t)HALF * K * 2;
    const unsigned ldsw = (unsigned)wid * 1024u;
    const int aoff = lds_byte(wr * 64 + fr, fq * 8), boff = lds_byte(wc * 32 + fr, fq * 8);
#define G_SA(b, h) (((b) * 2 + (h)) * HTB)
#define G_SB(b, h) ((4 + (b) * 2 + (h)) * HTB)
#define G_STAGE(bufoff, gbase) do { _Pragma("unroll") for (int _i = 0; _i < 2; ++_i) \
        __builtin_amdgcn_global_load_lds((const unsigned*)((const char*)(gbase) + voff[_i]), (LAS unsigned*)(lds + (bufoff) + ldsw + _i * 8192), 16, 0, 0); } while (0)
#define G_LDA(dst, b, h) do { _Pragma("unroll") for (int m = 0; m < 4; ++m) _Pragma("unroll") for (int k = 0; k < 2; ++k) dst[m][k] = *(const LAS h16x8*)(lds + G_SA(b, h) + aoff + m * 2048 + k * 1024); } while (0)
#define G_LDB(dst, b, h) do { _Pragma("unroll") for (int n = 0; n < 2; ++n) _Pragma("unroll") for (int k = 0; k < 2; ++k) dst[n][k] = *(const LAS h16x8*)(lds + G_SB(b, h) + boff + n * 2048 + k * 1024); } while (0)
#define G_MMA(ai, bj, At, Bt) do { __builtin_amdgcn_s_setprio(1); _Pragma("unroll") for (int m = 0; m < 4; ++m) _Pragma("unroll") for (int n = 0; n < 2; ++n) _Pragma("unroll") for (int k = 0; k < 2; ++k) \
        acc[ai][bj][m][n] = __builtin_amdgcn_mfma_f32_16x16x32_f16(Bt[n][k], At[m][k], acc[ai][bj][m][n], 0, 0, 0); __builtin_amdgcn_s_setprio(0); } while (0)
#define G_WAIT_V(n) asm volatile("s_waitcnt vmcnt(" #n ")" ::: "memory")
#define G_WAIT_L(n) asm volatile("s_waitcnt lgkmcnt(" #n ")" ::: "memory")
#define G_BAR __builtin_amdgcn_s_barrier()
#define G_SCHED __builtin_amdgcn_sched_barrier(0)
    Unit cur, nxt; int ui = 0;
    const int bid = opaque_bid();
    if (!S.next(0, cur, bid)) return;
    Acc acc;
#pragma unroll
    for (int a = 0; a < 2; ++a)
#pragma unroll
        for (int b = 0; b < 2; ++b)
#pragma unroll
            for (int m = 0; m < 4; ++m)
#pragma unroll
                for (int n = 0; n < 2; ++n) acc[a][b][m][n] = (f32x4){0.f, 0.f, 0.f, 0.f};
    h16x8 At[4][2], B0[2][2], B1[2][2];
    const char* cA = cur.A; const char* cB = cur.B;
    G_STAGE(G_SB(0, 0), cB); G_STAGE(G_SA(0, 0), cA); G_STAGE(G_SB(0, 1), cB + hstep); G_STAGE(G_SA(0, 1), cA + hstep);
    if (wr == 1) G_BAR;
    G_WAIT_V(4); G_BAR;
    G_STAGE(G_SB(1, 0), cB + kstep); G_STAGE(G_SA(1, 0), cA + kstep); G_STAGE(G_SB(1, 1), cB + hstep + kstep);
    G_WAIT_V(6); G_BAR;
    for (;;) {
        const bool has_next = S.next(ui + 1, nxt, bid);
        const char* nA = has_next ? nxt.A : cA; const char* nB = has_next ? nxt.B : cB;
        const int nt = cur.nt;
        for (int t = 0; t < nt; t += 2) {
            const bool last = (t == nt - 2);
            const char* a1 = cA + (size_t)(t + 1) * kstep;
            const char* a2 = last ? nA : cA + (size_t)(t + 2) * kstep; const char* b2 = last ? nB : cB + (size_t)(t + 2) * kstep;
            const char* a3 = a2 + kstep; const char* b3 = b2 + kstep;
            G_LDB(B0, 0, 0); G_SCHED; G_LDA(At, 0, 0); G_STAGE(G_SA(1, 1), a1 + hstep);
            G_WAIT_L(8); G_BAR; G_WAIT_L(0); G_MMA(0, 0, At, B0); G_BAR; G_SCHED;
            G_LDB(B1, 0, 1); G_STAGE(G_SB(0, 0), b2);
            G_BAR; G_WAIT_L(0); G_MMA(0, 1, At, B1); G_BAR;
            G_LDA(At, 0, 1); G_STAGE(G_SA(0, 0), a2);
            G_BAR; G_WAIT_L(0); G_MMA(1, 0, At, B0); G_BAR; G_SCHED;
            G_STAGE(G_SB(0, 1), b2 + hstep);
            G_WAIT_V(6); G_BAR; G_MMA(1, 1, At, B1); G_BAR;
            G_LDB(B0, 1, 0); G_SCHED; G_LDA(At, 1, 0); G_STAGE(G_SA(0, 1), a2 + hstep);
            G_WAIT_L(8); G_BAR; G_WAIT_L(0); G_MMA(0, 0, At, B0); G_BAR; G_SCHED;
            G_LDB(B1, 1, 1); G_STAGE(G_SB(1, 0), b3);
            G_BAR; G_WAIT_L(0); G_MMA(0, 1, At, B1); G_BAR;
            G_LDA(At, 1, 1); G_STAGE(G_SA(1, 0), a3);
            G_BAR; G_WAIT_L(0); G_MMA(1, 0, At, B0); G_BAR; G_SCHED;
            G_STAGE(G_SB(1, 1), b3 + hstep);
            G_WAIT_V(6); G_BAR; G_MMA(1, 1, At, B1); G_BAR;
        }
        S.epi(acc, cur, wr, wc, fr, fq);
        if (!S.keep(cur)) {
#pragma unroll
            for (int a = 0; a < 2; ++a)
#pragma unroll
                for (int b = 0; b < 2; ++b)
#pragma unroll
                    for (int m = 0; m < 4; ++m)
#pragma unroll
                        for (int n = 0; n < 2; ++n) acc[a][b][m][n] = (f32x4){0.f, 0.f, 0.f, 0.f};
        }
        if (!has_next) break;
        cur = nxt; cA = nA; cB = nB; ++ui;
    }
    G_WAIT_V(0);
    if (wr == 0) G_BAR;
    G_BAR;
}

__device__ __forceinline__ void phase_setup(const Ctx& p, LAS unsigned char* lds) {
    const int tid = opaque_tid(p.wv), nb = gridDim.x, b = opaque_bid();
    float* cosT = (float*)(p.ws + OFF_ROPE); float* sinT = cosT + 256 * 32;
    for (int i = b * 512 + tid; i < 256 * 32; i += nb * 512) {
        const int pos = i >> 5, f = i & 31;
        const float inv = exp2f(-(float)f * (13.287712379549449f / 32.0f));
        const float ang = (float)pos * inv;
        const double rev = (double)ang * 0.15915494309189535;
        const float fr = (float)(rev - floor(rev));
        cosT[i] = __builtin_amdgcn_cosf(fr); sinT[i] = __builtin_amdgcn_sinf(fr);
    }
    float* mod = (float*)(p.ws + OFF_MOD);
    LAS float* red = (LAS float*)lds;
    for (int it = b; it < 4 * 144; it += nb) {
        const int l = it / 144, cgp = it % 144, ct = tid & 15, sl = tid >> 4;
        const float* wm = p.w_mod + (size_t)l * D * 9216 + cgp * 64 + ct * 4;
        f32x4 ax = {0.f, 0.f, 0.f, 0.f}, ac = {0.f, 0.f, 0.f, 0.f};
#pragma unroll 8
        for (int r = 0; r < 32; ++r) { const int i = sl * 32 + r; const float cx = p.c[i], cc = p.c_ctx[i];
            const float sx = cx / (1.0f + expf(-cx)), sc = cc / (1.0f + expf(-cc));
            const f32x4 w = *(const f32x4*)(wm + (size_t)i * 9216); ax += w * sx; ac += w * sc; }
        *(LAS f32x4*)(red + (sl * 16 + ct) * 8) = ax; *(LAS f32x4*)(red + (sl * 16 + ct) * 8 + 4) = ac;
        __syncthreads();
        if (tid < 128) { const int s = tid >> 6, cc = tid & 63, ct2 = cc >> 2, comp = cc & 3; float sum = 0.f;
#pragma unroll 8
            for (int q = 0; q < 32; ++q) sum += red[(q * 16 + ct2) * 8 + s * 4 + comp];
            const int col = cgp * 64 + cc; mod[(size_t)(l * 2 + s) * 9216 + col] = sum + p.b_mod[(size_t)l * 9216 + col]; }
        __syncthreads();
    }
}

__device__ __forceinline__ int slot32(int s32) { return 16 * ((s32 >> 2) & 1) + 4 * (s32 >> 3) + (s32 & 3); }
__device__ __forceinline__ int perm_row(int kind, int s) {
    if (kind == 1) { const int part = s / DFF, hidx = s % DFF, pn = hidx >> 7, rem = hidx & 127; return pn * 256 + part * 128 + (rem & ~31) + slot32(rem & 31); }
    if (kind == 2) { const int head = s >> 7, phi = s & 127; return head * 128 + 32 * (2 * (phi >> 6) + ((phi & 31) >> 4)) + 16 * ((phi & 63) >> 5) + (phi & 15); }
    if (kind == 3) return (s & ~31) + slot32(s & 31);
    if (kind == 4) { const int part = s >> 10, ch = s & 1023, t = ch >> 7, rem = ch & 127; return t * 256 + part * 128 + (rem & ~31) + slot32(rem & 31); }
    return s;
}
__device__ __forceinline__ void cvt_job(const float* W, int ldw, int c0, int ncols, int K, h16* WT, int kind, LAS float* scr, int gw, int NGW, int lane) {
    const int nblk = ncols / 32, nitems = (K / 64) * nblk;
    f32x4 pre[8];
    if (gw < nitems) { const int kb = gw / nblk, nbk = gw % nblk;
#pragma unroll
        for (int i = 0; i < 8; ++i) pre[i] = *(const f32x4*)(W + (size_t)(64 * kb + 8 * i + (lane >> 3)) * ldw + c0 + 32 * nbk + (lane & 7) * 4); }
    for (int item = gw; item < nitems; item += NGW) {
        const int kb = item / nblk, nbk = item % nblk, k0 = 64 * kb, n0 = 32 * nbk;
#pragma unroll
        for (int i = 0; i < 8; ++i) { const int kk = 8 * i + (lane >> 3), nn = (lane & 7) * 4; const f32x4 v = pre[i];
            scr[kk * 33 + nn] = v.x; scr[kk * 33 + nn + 1] = v.y; scr[kk * 33 + nn + 2] = v.z; scr[kk * 33 + nn + 3] = v.w; }
        if (item + NGW < nitems) { const int kb2 = (item + NGW) / nblk, nbk2 = (item + NGW) % nblk;
#pragma unroll
            for (int i = 0; i < 8; ++i) pre[i] = *(const f32x4*)(W + (size_t)(64 * kb2 + 8 * i + (lane >> 3)) * ldw + c0 + 32 * nbk2 + (lane & 7) * 4); }
        asm volatile("s_waitcnt lgkmcnt(0)" ::: "memory");
        const int c = lane & 7;
#pragma unroll
        for (int j = 0; j < 4; ++j) { const int n = (lane >> 3) + 8 * j; const LAS float* s = scr + (8 * c) * 33 + n;
            h16x8 o;
#pragma unroll
            for (int e = 0; e < 8; ++e) o[e] = (h16)s[e * 33];
            *(h16x8*)(WT + (size_t)perm_row(kind, n0 + n) * K + k0 + 8 * c) = o; }
        asm volatile("s_waitcnt lgkmcnt(0)" ::: "memory");
    }
}
__device__ __forceinline__ void phase_cvt(const Ctx& p, int l, LAS unsigned char* lds, int skip) {
    const int tid = opaque_tid(p.wv), wv = tid >> 6, lane = tid & 63, bid = opaque_bid(), gw = (bid - skip) * 8 + wv, NGW = ((int)gridDim.x - skip) * 8;
    if (bid < skip) return;
    LAS float* scr = (LAS float*)(lds + wv * 8448);
    h16* W = (h16*)(p.ws + OFF_W) + (size_t)(l & 1) * W_END;
    const float* win = p.w_in + (size_t)l * D * 8192;
    cvt_job(p.f1u + (size_t)l * D * NUP, NUP, 0, NUP, D, W + W_UP1, 1, scr, gw, NGW, lane);
    cvt_job(p.f1d + (size_t)l * DFF * D, D, 0, D, DFF, W + W_DN1, 3, scr, gw, NGW, lane);
    cvt_job(win, 8192, 0, 1536, D, W + W_KV, 0, scr, gw, NGW, lane);
    cvt_job(win, 8192, 0, 512, D, W + W_N, 2, scr, gw, NGW, lane);
    cvt_job(win, 8192, 1536, 512, D, W + W_N + (size_t)512 * D, 2, scr, gw, NGW, lane);
    cvt_job(win, 8192, 2048, 2048, D, W + W_N + (size_t)1024 * D, 3, scr, gw, NGW, lane);
    cvt_job(win, 8192, 4096, 2048, D, W + W_N + (size_t)3072 * D, 4, scr, gw, NGW, lane);
    cvt_job(win, 8192, 6144, 2048, D, W + W_N + (size_t)5120 * D, 3, scr, gw, NGW, lane);
    cvt_job(p.wro + (size_t)l * D * D, D, 0, D, D, W + W_RO, 3, scr, gw, NGW, lane);
    cvt_job(p.wco + (size_t)l * D * D, D, 0, D, D, W + W_CO, 3, scr, gw, NGW, lane);
    cvt_job(p.wo + (size_t)l * D * D, D, 0, D, D, W + W_O, 3, scr, gw, NGW, lane);
    cvt_job(p.f2u + (size_t)l * D * NUP, NUP, 0, NUP, D, W + W_UP2, 1, scr, gw, NGW, lane);
    cvt_job(p.f2d + (size_t)l * DFF * D, D, 0, D, DFF, W + W_DN2, 3, scr, gw, NGW, lane);
}

__device__ __forceinline__ void phase_norm(const Ctx& p, int l, int sub, int nsl, bool first = false) {
    const int tid = opaque_tid(p.wv), lane = tid & 63, gw = opaque_bid() * 8 + (tid >> 6), NGW = gridDim.x * 8;
    h16* X = (h16*)(p.ws + OFF_X); h16* Y = (h16*)(p.ws + OFF_Y); const float* PART = (const float*)(p.ws + OFF_PART);
    const float* nw = p.norm_w + (size_t)(l * 3 + sub) * D;
    const float* mod = (const float*)(p.ws + OFF_MOD);
    const float* ml = mod + (size_t)(l * 2) * 9216; const float* mc = ml + 9216;
#define NCOL(j) (8 * lane + 512 * ((j) >> 1) + 4 * ((j) & 1))
    f32x4 wl[4], sl4[4];
#pragma unroll
    for (int j = 0; j < 4; ++j) { const int col = NCOL(j);
        wl[j] = *(const f32x4*)(nw + col) * (*(const f32x4*)(ml + (3 * sub + 1) * D + col) + 1.0f); sl4[j] = *(const f32x4*)(ml + (3 * sub) * D + col); }
    h16x8 tn[2];
    if (!first && gw < M) { tn[0] = *(const h16x8*)(X + (size_t)gw * D + 8 * lane); tn[1] = *(const h16x8*)(X + (size_t)gw * D + 8 * lane + 512); }
    for (int row = gw; row < M; row += NGW) {
        h16* xrow = X + (size_t)row * D; h16* yrow = Y + (size_t)row * D;
        f32x4 v[4]; float ss = 0.f;
        if (first) { const float* x32 = row < CTX ? p.ctx + (size_t)row * D : p.x + (size_t)(row - CTX) * D;
#pragma unroll
            for (int j = 0; j < 4; ++j) v[j] = *(const f32x4*)(x32 + NCOL(j));
#pragma unroll
            for (int q = 0; q < 2; ++q) { h16x8 o;
#pragma unroll
                for (int e = 0; e < 4; ++e) { o[e] = (h16)v[2 * q][e]; o[4 + e] = (h16)v[2 * q + 1][e]; }
                *(h16x8*)(xrow + 8 * lane + 512 * q) = o; }
        } else {
#pragma unroll
            for (int q = 0; q < 2; ++q) { const h16x8 t = tn[q];
#pragma unroll
                for (int e = 0; e < 4; ++e) { v[2 * q][e] = (float)t[e]; v[2 * q + 1][e] = (float)t[4 + e]; } }
            if (row + NGW < M) { tn[0] = *(const h16x8*)(xrow + (size_t)NGW * D + 8 * lane); tn[1] = *(const h16x8*)(xrow + (size_t)NGW * D + 8 * lane + 512); }
        }
        const bool isctx = row < CTX;
        if (isctx && nsl > 0) {
            for (int s0 = 0; s0 < nsl; s0 += 4) { f32x4 pv[4][4];
#pragma unroll
                for (int q = 0; q < 4; ++q) { const int sl = (s0 + q < nsl) ? s0 + q : nsl - 1; const float* pr = PART + (size_t)sl * CTX * D + (size_t)row * D;
#pragma unroll
                    for (int j = 0; j < 4; ++j) pv[q][j] = *(const f32x4*)(pr + NCOL(j)); }
#pragma unroll
                for (int q = 0; q < 4; ++q) if (s0 + q < nsl) {
#pragma unroll
                    for (int j = 0; j < 4; ++j) v[j] += pv[q][j]; } }
#pragma unroll
            for (int q = 0; q < 2; ++q) { h16x8 o;
#pragma unroll
                for (int e = 0; e < 4; ++e) { o[e] = (h16)v[2 * q][e]; o[4 + e] = (h16)v[2 * q + 1][e]; }
                *(h16x8*)(xrow + 8 * lane + 512 * q) = o; }
        }
#pragma unroll
        for (int j = 0; j < 4; ++j) ss += v[j].x * v[j].x + v[j].y * v[j].y + v[j].z * v[j].z + v[j].w * v[j].w;
        ss = wave_sum(ss);
        const float rs = __builtin_amdgcn_rsqf(ss * (1.0f / D) + NEPS);
        f32x4 y[4];
        if (isctx) {
#pragma unroll
            for (int j = 0; j < 4; ++j) { const int col = NCOL(j);
                const f32x4 w = *(const f32x4*)(nw + col), sc = *(const f32x4*)(mc + (3 * sub + 1) * D + col), sh = *(const f32x4*)(mc + (3 * sub) * D + col);
                y[j] = (v[j] * rs) * w * (sc + 1.0f) + sh; }
        } else {
#pragma unroll
            for (int j = 0; j < 4; ++j) y[j] = (v[j] * rs) * wl[j] + sl4[j];
        }
#pragma unroll
        for (int q = 0; q < 2; ++q) { h16x8 o;
#pragma unroll
            for (int e = 0; e < 4; ++e) { o[e] = (h16)y[2 * q][e]; o[4 + e] = (h16)y[2 * q + 1][e]; }
            *(h16x8*)(yrow + 8 * lane + 512 * q) = o; }
    }
#undef NCOL
}
__device__ __forceinline__ void phase_final(const Ctx& p) {
    const int tid = opaque_tid(p.wv), lane = tid & 63, gw = opaque_bid() * 8 + (tid >> 6), NGW = gridDim.x * 8;
    const h16* X = (const h16*)(p.ws + OFF_X);
    f32x4 fw[4];
#pragma unroll
    for (int j = 0; j < 4; ++j) fw[j] = *(const f32x4*)(p.fnw + 8 * lane + 512 * (j >> 1) + 4 * (j & 1));
    h16x8 tn[2];
    if (gw < SEQ) { tn[0] = *(const h16x8*)(X + (size_t)(gw + CTX) * D + 8 * lane); tn[1] = *(const h16x8*)(X + (size_t)(gw + CTX) * D + 8 * lane + 512); }
    for (int row = gw; row < SEQ; row += NGW) {
        const h16* xrow = X + (size_t)(row + CTX) * D;
        f32x4 v[4]; float ss = 0.f;
        const h16x8 tc0 = tn[0], tc1 = tn[1];
        if (row + NGW < SEQ) { tn[0] = *(const h16x8*)(xrow + (size_t)NGW * D + 8 * lane); tn[1] = *(const h16x8*)(xrow + (size_t)NGW * D + 8 * lane + 512); }
#pragma unroll
        for (int q = 0; q < 2; ++q) { const h16x8 t = q ? tc1 : tc0;
#pragma unroll
            for (int e = 0; e < 4; ++e) { v[2 * q][e] = (float)t[e]; v[2 * q + 1][e] = (float)t[4 + e]; } }
#pragma unroll
        for (int j = 0; j < 4; ++j) ss += v[j].x * v[j].x + v[j].y * v[j].y + v[j].z * v[j].z + v[j].w * v[j].w;
        ss = wave_sum(ss);
        const float rs = __builtin_amdgcn_rsqf(ss * (1.0f / D) + NEPS);
#pragma unroll
        for (int j = 0; j < 4; ++j) { const int col = 8 * lane + 512 * (j >> 1) + 4 * (j & 1);
            *(f32x4*)(p.out + (size_t)row * D + col) = (v[j] * rs) * fw[j]; }
    }
}

#define MFMA16(a, b, c) __builtin_amdgcn_mfma_f32_16x16x32_f16(a, b, c, 0, 0, 0)

__device__ __forceinline__ void phase_kv(const Ctx& p, int l, LAS unsigned char* lds) {
    const int tid = opaque_tid(p.wv), w = tid >> 6, lane = tid & 63, fr = lane & 15, fq = lane >> 4, bid = opaque_bid();
    LAS h16* Vs = (LAS h16*)lds; LAS h16* Kf = Vs + 256 * 136; LAS h16* Kb = Kf + 128 * 136; LAS float* wt = (LAS float*)(Kb + 128 * 136);
    const h16* kT = (const h16*)(p.ws + OFF_RA + SZ_SB); const h16* vT = (const h16*)(p.ws + OFF_VT); h16* SB = (h16*)(p.ws + OFF_RA);
    u32x4 vreg[8]; h16x8 kreg[4];
#define KV_ISSUE(uu) do { const int _c = (uu) >> 2, _h = (uu) & 3; \
        _Pragma("unroll") for (int i = 0; i < 8; ++i) { const int ch = tid + 512 * i, r = ch >> 4, cc = ch & 15; vreg[i] = *(const u32x4*)(vT + (size_t)(_h * 256 + r) * M + _c * 128 + cc * 8); } \
        _Pragma("unroll") for (int i = 0; i < 4; ++i) { const int ch = tid + 512 * i, r = ch >> 4, cc = ch & 15; kreg[i] = *(const h16x8*)(kT + (size_t)(_h * 128 + r) * M + _c * 128 + cc * 8); } } while (0)
    if (bid < NCH * 4) KV_ISSUE(bid);
    for (int u = bid; u < NCH * 4; u += gridDim.x) {
        const int c = u >> 2, h = u & 3;
        const float lgf = p.rld[(l * 2 + 0) * 4 + h] * LOG2E, lgb = p.rld[(l * 2 + 1) * 4 + h] * LOG2E;
        if (tid < 128) { wt[tid] = exp2f(lgf * (float)(127 - tid)); wt[128 + tid] = exp2f(lgb * (float)tid); }
#pragma unroll
        for (int i = 0; i < 8; ++i) { const int ch = tid + 512 * i, r = ch >> 4, cc = ch & 15; *(LAS u32x4*)(Vs + r * 136 + cc * 8) = vreg[i]; }
        __syncthreads();
#pragma unroll
        for (int i = 0; i < 4; ++i) { const int ch = tid + 512 * i, r = ch >> 4, cc = ch & 15, rs = (r & ~31) + slot32(r & 31);
            const h16x8 k = kreg[i]; h16x8 a, b2;
#pragma unroll
            for (int e = 0; e < 8; ++e) { const float kv = (float)k[e]; a[e] = (h16)(kv * wt[cc * 8 + e]); b2[e] = (h16)(kv * wt[128 + cc * 8 + e]); }
            *(LAS h16x8*)(Kf + rs * 136 + cc * 8) = a; *(LAS h16x8*)(Kb + rs * 136 + cc * 8) = b2; }
        __syncthreads();
        if (u + (int)gridDim.x < NCH * 4) KV_ISSUE(u + (int)gridDim.x);
#pragma unroll 1
        for (int dir = 0; dir < 2; ++dir) {
            const LAS h16* Kd = dir ? Kb : Kf;
            f32x4 acc[2][8];
#pragma unroll
            for (int a = 0; a < 2; ++a)
#pragma unroll
                for (int b = 0; b < 8; ++b) acc[a][b] = (f32x4){0.f, 0.f, 0.f, 0.f};
#pragma unroll
            for (int ks = 0; ks < 4; ++ks) { h16x8 vf[2];
#pragma unroll
                for (int ef = 0; ef < 2; ++ef) vf[ef] = *(const LAS h16x8*)(Vs + (32 * w + 16 * ef + fr) * 136 + ks * 32 + fq * 8);
#pragma unroll
                for (int df = 0; df < 8; ++df) { const h16x8 a = *(const LAS h16x8*)(Kd + (16 * df + fr) * 136 + ks * 32 + fq * 8);
#pragma unroll
                    for (int ef = 0; ef < 2; ++ef) acc[ef][df] = MFMA16(a, vf[ef], acc[ef][df]); } }
#pragma unroll
            for (int ef = 0; ef < 2; ++ef)
#pragma unroll
                for (int dp = 0; dp < 4; ++dp) { h16x8 o;
#pragma unroll
                    for (int j = 0; j < 4; ++j) { o[j] = (h16)acc[ef][2 * dp][j]; o[4 + j] = (h16)acc[ef][2 * dp + 1][j]; }
                    *(h16x8*)(SB + (size_t)(c * 8 + h * 2 + dir) * 32768 + (32 * w + 16 * ef + fr) * 128 + 32 * dp + 8 * fq) = o; }
        }
        __syncthreads();
    }
#undef KV_ISSUE
    const h16* P = (const h16*)(p.ws + OFF_P); h16* Aconv = (h16*)(p.ws + OFF_AC) + (size_t)M * D;
    const int tq = tid >> 7, ch = (tid & 127) * 8;
    float w0[8], w1[8], w2[8];
#pragma unroll
    for (int e = 0; e < 8; ++e) { w0[e] = p.conv_w[(size_t)(l * 3 + 0) * D + ch + e]; w1[e] = p.conv_w[(size_t)(l * 3 + 1) * D + ch + e]; w2[e] = p.conv_w[(size_t)(l * 3 + 2) * D + ch + e]; }
    for (int it = (int)gridDim.x - 1 - bid; it < M / 64; it += gridDim.x) {
        const int t0 = it * 64 + 16 * tq;
        h16x8 ur[18], cbr[16];
        const h16x8 zero8 = {0, 0, 0, 0, 0, 0, 0, 0};
        ur[0] = (t0 == 0 || t0 == CTX) ? zero8 : *(const h16x8*)(P + (size_t)(t0 - 1) * PW + PC_U + ch);
#pragma unroll
        for (int k = 1; k < 17; ++k) ur[k] = *(const h16x8*)(P + (size_t)(t0 - 1 + k) * PW + PC_U + ch);
        ur[17] = (t0 + 16 == CTX || t0 + 16 == M) ? zero8 : *(const h16x8*)(P + (size_t)(t0 + 16) * PW + PC_U + ch);
#pragma unroll
        for (int k = 0; k < 16; ++k) cbr[k] = *(const h16x8*)(P + (size_t)(t0 + k) * PW + PC_CB + ch);
#pragma unroll
        for (int k = 0; k < 16; ++k) { h16x8 o;
#pragma unroll
            for (int e = 0; e < 8; ++e) o[e] = (h16)((float)cbr[k][e] * (w0[e] * (float)ur[k][e] + w1[e] * (float)ur[k + 1][e] + w2[e] * (float)ur[k + 2][e]));
            *(h16x8*)(Aconv + (size_t)(t0 + k) * D + ch) = o; }
    }
}

template <int DIR> __device__ __forceinline__ void scan_chain(h16x2* base, float Dc) {
#define SCAN_IDX(kk) (DIR ? ((kk) < 2 ? 1 - (kk) : NCH + 1 - (kk)) : (kk))
    float r0 = 0.f, r1 = 0.f;
    h16x2 cur[26], nxt[26];
#pragma unroll
    for (int k = 0; k < 26; ++k) cur[k] = base[(size_t)SCAN_IDX(k) * 131072];
#pragma unroll
    for (int bt = 0; bt < NCH / 26; ++bt) {
        if (bt + 1 < NCH / 26) {
#pragma unroll
            for (int k = 0; k < 26; ++k) nxt[k] = base[(size_t)SCAN_IDX(26 * (bt + 1) + k) * 131072]; }
        __builtin_amdgcn_sched_barrier(0);
#pragma unroll
        for (int k = 0; k < 26; ++k) { h16x2 o; o.x = (h16)r0; o.y = (h16)r1; base[(size_t)SCAN_IDX(26 * bt + k) * 131072] = o;
            r0 = Dc * r0 + (float)cur[k].x; r1 = Dc * r1 + (float)cur[k].y; }
        if (bt + 1 < NCH / 26) {
#pragma unroll
            for (int k = 0; k < 26; ++k) cur[k] = nxt[k]; }
    }
#undef SCAN_IDX
}
__device__ __forceinline__ void phase_scan(const Ctx& p, int l) {
    h16x2* SB = (h16x2*)(p.ws + OFF_RA);
    for (int g = opaque_bid() * 512 + opaque_tid(p.wv); g < 131072; g += gridDim.x * 512) {
        const int hd = g >> 14, pi = g & 16383, h = hd >> 1, dir = hd & 1;
        const float Dc = exp2f(p.rld[(l * 2 + dir) * 4 + h] * LOG2E * 128.0f);
        h16x2* base = SB + (size_t)hd * 16384 + pi;
        if (dir) scan_chain<1>(base, Dc); else scan_chain<0>(base, Dc);
    }
}

__device__ __forceinline__ void phase_ret(const Ctx& p, int l, LAS unsigned char* lds) {
    const int tid = opaque_tid(p.wv), w = tid >> 6, lane = tid & 63, fr = lane & 15, fq = lane >> 4, bid = opaque_bid();
    LAS h16* Ks = (LAS h16*)lds; LAS h16* Ps = Ks + 128 * 136; LAS h16* Bb = Ps + 128 * 136;
    const h16* P = (const h16*)(p.ws + OFF_P); const h16* vT = (const h16*)(p.ws + OFF_VT); const h16* SB = (const h16*)(p.ws + OFF_RA);
    h16* Aret = (h16*)(p.ws + OFF_AC);
    const int u0 = (l == DEPTH - 1) ? 8 : 0;
    for (int u = bid + u0; u < NCH * 4; u += gridDim.x) {
        const int c = u >> 2, h = u & 3, row0 = c * 128, il = 16 * w + fr;
        const float lgf = p.rld[(l * 2 + 0) * 4 + h] * LOG2E, lgb = p.rld[(l * 2 + 1) * 4 + h] * LOG2E;
        h16x8 qf[4];
        { const h16* qp = P + (size_t)(row0 + il) * PW + PC_Q + h * 128 + fq * 8;
#pragma unroll
          for (int ks = 0; ks < 4; ++ks) qf[ks] = *(const h16x8*)(qp + ks * 32); }
#pragma unroll
        for (int i = 0; i < 4; ++i) { const int ch = tid + 512 * i, r = ch >> 4, cc = ch & 15;
            *(LAS u32x4*)(Ks + r * 136 + cc * 8) = *(const u32x4*)(P + (size_t)(row0 + r) * PW + PC_K + h * 128 + cc * 8); }
        u32x4 breg[4];
#define RET_LOADB(hb) do { const int _eh = (hb) & 1; const h16* _b; size_t _st; \
            if ((hb) < 2) { _b = vT + (size_t)(h * 256 + 128 * _eh) * M + row0; _st = M; } \
            else { _b = SB + (size_t)(c * 8 + h * 2 + (((hb) >> 1) - 1)) * 32768 + (size_t)(128 * _eh) * 128; _st = 128; } \
            _Pragma("unroll") for (int i = 0; i < 4; ++i) { const int ch = tid + 512 * i, r = ch >> 4, cc = ch & 15; breg[i] = *(const u32x4*)(_b + (size_t)r * _st + cc * 8); } } while (0)
        RET_LOADB(0);
        __syncthreads();
        f32x4 s[8];
#pragma unroll
        for (int n = 0; n < 8; ++n) { s[n] = (f32x4){0.f, 0.f, 0.f, 0.f};
#pragma unroll
            for (int ks = 0; ks < 4; ++ks) s[n] = MFMA16(*(const LAS h16x8*)(Ks + (16 * n + fr) * 136 + ks * 32 + fq * 8), qf[ks], s[n]); }
#pragma unroll
        for (int n = 0; n < 8; ++n) { f32x4 v;
#pragma unroll
            for (int j = 0; j < 4; ++j) { const int rel = il - (16 * n + 4 * fq + j);
                const float mk = rel > 0 ? __builtin_amdgcn_exp2f(lgf * (float)rel) : (rel < 0 ? __builtin_amdgcn_exp2f(lgb * (float)(-rel)) : 2.0f);
                v[j] = s[n][j] * mk; }
            *(LAS h16x4*)(Ps + il * 136 + 16 * n + 4 * fq) = cvt4(v); }
        const h16 wqf = (h16)exp2f(lgf * (float)(il + 1)), wqb = (h16)exp2f(lgb * (float)(128 - il));
        f32x4 o[16];
#pragma unroll
        for (int n = 0; n < 16; ++n) o[n] = (f32x4){0.f, 0.f, 0.f, 0.f};
#pragma unroll 1
        for (int hp = 0; hp < 3; ++hp) {
            h16x8 af[4];
            if (hp == 0) {
#pragma unroll
                for (int ks = 0; ks < 4; ++ks) af[ks] = *(const LAS h16x8*)(Ps + il * 136 + ks * 32 + fq * 8);
            } else { const h16 wq = hp == 1 ? wqf : wqb;
#pragma unroll
                for (int ks = 0; ks < 4; ++ks) af[ks] = qf[ks] * wq; }
#pragma unroll
            for (int eh = 0; eh < 2; ++eh) {
                const int hb = hp * 2 + eh;
                LAS h16* B = Bb + eh * (128 * 136);
#pragma unroll
                for (int i = 0; i < 4; ++i) { const int ch = tid + 512 * i, r = ch >> 4, cc = ch & 15; *(LAS u32x4*)(B + ((r & ~31) + slot32(r & 31)) * 136 + cc * 8) = breg[i]; }
                if (hb < 5) RET_LOADB(hb + 1);
                __syncthreads();
#pragma unroll
                for (int nf = 0; nf < 8; ++nf)
#pragma unroll
                    for (int ks = 0; ks < 4; ++ks) o[eh * 8 + nf] = MFMA16(*(const LAS h16x8*)(B + (16 * nf + fr) * 136 + ks * 32 + fq * 8), af[ks], o[eh * 8 + nf]);
            }
        }
        float ss = 0.f;
#pragma unroll
        for (int n = 0; n < 16; ++n) ss += o[n].x * o[n].x + o[n].y * o[n].y + o[n].z * o[n].z + o[n].w * o[n].w;
        ss += __shfl_xor(ss, 16); ss += __shfl_xor(ss, 32);
        const float rs = __builtin_amdgcn_rsqf(ss * (1.0f / 256.0f) + NEPS);
        const h16* gp = P + (size_t)(row0 + il) * PW + PC_G + h * 256 + 8 * fq; h16* op = Aret + (size_t)(row0 + il) * D + h * 256 + 8 * fq;
        h16x8 gq[8];
#pragma unroll
        for (int np = 0; np < 8; ++np) gq[np] = *(const h16x8*)(gp + 32 * np);
        __builtin_amdgcn_sched_barrier(0);
#pragma unroll
        for (int np = 0; np < 8; ++np) { const h16x8 g = gq[np]; h16x8 v;
#pragma unroll
            for (int j = 0; j < 4; ++j) { v[j] = (h16)(silu((float)g[j]) * o[2 * np][j] * rs); v[4 + j] = (h16)(silu((float)g[4 + j]) * o[2 * np + 1][j] * rs); }
            *(h16x8*)(op + 32 * np) = v; }
        __syncthreads();
    }
}

#define XB_TMO      128
#define XB_XCNT(j)  (256  + 64 * (j))
#define XB_XSUB(j)  (1280 + 64 * (j))
#define XB_XGEN(j)  (2304 + 64 * (j))
#define XB_TOP      3328
#define XB_TOPGEN   3392
#define XB_WORDS    3456
#define XB_SPIN_CAP (1u << 20)
__device__ __forceinline__ unsigned xb_ld(unsigned* p) { return __hip_atomic_load(p, __ATOMIC_RELAXED, __HIP_MEMORY_SCOPE_AGENT); }
__device__ __forceinline__ unsigned xb_add(unsigned* p, unsigned v) { return __hip_atomic_fetch_add(p, v, __ATOMIC_RELAXED, __HIP_MEMORY_SCOPE_AGENT); }
__device__ __forceinline__ unsigned xb_xcc_id() { return (unsigned)__builtin_amdgcn_s_getreg((3 << 11) | 20) & 0xFu; }
#define XB_SPIN(cond, bar) do { unsigned _sp = 0; while (cond) { __builtin_amdgcn_s_sleep(1); \
    if ((++_sp & 255u) == 0u) { if (xb_ld(&(bar)[XB_TMO])) break; if (_sp > XB_SPIN_CAP) { atomicAdd(&(bar)[XB_TMO], 1u); break; } } } } while (0)
__device__ __forceinline__ void grid_barrier(unsigned* bar, volatile LAS unsigned* st, int wv) {
    asm volatile("s_waitcnt vmcnt(0)" ::: "memory");
    __syncthreads();
    if (opaque_tid(wv) == 0) {
        __builtin_amdgcn_s_waitcnt(0);
        const unsigned x = xb_xcc_id();
        unsigned nloc = st[0], nx = st[1];
        if (nloc == 0u) {
            const unsigned G = gridDim.x; unsigned sum, cnt, mine, sp = 0u;
            for (;;) { sum = 0u; cnt = 0u; mine = 0u;
#pragma unroll
                for (unsigned j = 0; j < 16; ++j) { const unsigned c = xb_ld(&bar[XB_XCNT(j)]); sum += c; cnt += (c > 0u) ? 1u : 0u; mine = (j == x) ? c : mine; }
                if (sum == G) break;
                __builtin_amdgcn_s_sleep(1);
                if ((++sp & 255u) == 0u) { if (xb_ld(&bar[XB_TMO])) break; if (sp > XB_SPIN_CAP) { atomicAdd(&bar[XB_TMO], 1u); break; } } }
            nloc = mine > 0u ? mine : 1u; nx = cnt > 0u ? cnt : 1u; st[0] = nloc; st[1] = nx; }
        const unsigned old = xb_add(&bar[XB_XSUB(x)], 1u);
        const unsigned gen = old / nloc;
        if (old + 1u == (gen + 1u) * nloc) {
            __builtin_amdgcn_fence(__ATOMIC_RELEASE, "agent");
            asm volatile("s_waitcnt vmcnt(0)" ::: "memory");
            const unsigned og = xb_add(&bar[XB_TOP], 1u);
            const unsigned tg = og / nx;
            if (og + 1u == (tg + 1u) * nx) xb_add(&bar[XB_TOPGEN], 1u);
            else XB_SPIN(xb_ld(&bar[XB_TOPGEN]) == tg, bar);
            __builtin_amdgcn_fence(__ATOMIC_ACQUIRE, "agent");
            xb_add(&bar[XB_XGEN(x)], 1u);
            asm volatile("s_waitcnt vmcnt(0)" ::: "memory");
        } else {
            XB_SPIN(xb_ld(&bar[XB_XGEN(x)]) == gen, bar);
            __builtin_amdgcn_fence(__ATOMIC_ACQUIRE, "agent");
            asm volatile("s_waitcnt vmcnt(0)" ::: "memory");
        }
    }
    __syncthreads();
}
__global__ void __launch_bounds__(512, 2) fwd_megakernel(Params p0) {
    extern __shared__ __attribute__((aligned(16))) unsigned char smem[];
    LAS unsigned char* lds = (LAS unsigned char*)smem;
    Ctx p; *(Params*)&p = p0; p.wv = __builtin_amdgcn_readfirstlane(threadIdx.x >> 6);
    if (p.ph_hi < 0) cg::this_grid().sync();
    unsigned* bar = (unsigned*)(p.ws + OFF_BAR);
    volatile LAS unsigned* st = (volatile LAS unsigned*)(lds + LDS_BYTES - 16);
    if (threadIdx.x == 0) { st[0] = 0u; st[1] = 0u; (void)xb_add(&bar[XB_XCNT(xb_xcc_id())], 1u); }
    __syncthreads();
    int ph = 0;
#define DUPP(bit, ...) do { __VA_ARGS__; if (DUP_MASK & (bit)) { __VA_ARGS__; } } while (0)
#define PHASE(...) do { if (ph >= p.ph_lo && ph < p.ph_hi) { if (ph > p.ph_lo) grid_barrier(bar, st, p.wv); __VA_ARGS__; } ++ph; } while (0)
    const char* ws = (const char*)p.ws;
    const float* mod = (const float*)(p.ws + OFF_MOD);
    const float* cosT = (const float*)(p.ws + OFF_ROPE); const float* sinT = cosT + 256 * 32;
    PHASE({ phase_setup(p, lds); phase_cvt(p, 0, lds, 0); });
#pragma unroll 1
    for (int l = 0; l < DEPTH; ++l) {
        const float* ml = mod + (size_t)(l * 2) * 9216; const float* mc = ml + 9216;
        const h16* Wt = (const h16*)(p.ws + OFF_W) + (size_t)(l & 1) * W_END;
        PHASE(phase_norm(p, l, 0, l ? 11 : 0, l == 0));
#pragma unroll 1
        for (int f = 0; f < 2; ++f) {
            if (f == 1) {
                PHASE(DUPP(2, phase_norm(p, l, 1, 11)));
                PHASE({ Pol<G_INP> S{}; S.A = ws + OFF_Y; S.B = (const char*)(Wt + W_N); S.A2 = (const char*)(Wt + W_KV); S.nM = 65; S.nN = 34; S.K = D;
                        S.O = (h16*)(p.ws + OFF_P); S.O2 = (h16*)(p.ws + OFF_RA + SZ_SB); S.O3 = (h16*)(p.ws + OFF_VT); S.cosT = cosT; S.sinT = sinT; DUPP(32, gemm_phase(lds, S, p.wv)); });
                PHASE(DUPP(4, phase_kv(p, l, lds)));
                PHASE(phase_scan(p, l));
                PHASE(DUPP(8, phase_ret(p, l, lds)));
                PHASE({ Pol<G_YG> S{}; S.A = ws + OFF_AC; S.B = (const char*)(Wt + W_RO); S.A2 = ws + OFF_AC + (size_t)M * D * 2; S.B2 = (const char*)(Wt + W_CO); S.nM = 65; S.nN = 4; S.K = D;
                        S.O = (h16*)(p.ws + OFF_Y); S.P = (const h16*)(p.ws + OFF_P);
                        const bool cvt_first = (l + 1 < DEPTH) && (blockIdx.x & 1);
                        if (cvt_first) { phase_cvt(p, l + 1, lds, gridDim.x > 16 ? 8 : 0); __syncthreads(); }
                        DUPP(64, gemm_phase(lds, S, p.wv));
                        if (l + 1 < DEPTH) { Pol<G_YGC> C{}; C.A = S.A; C.B = S.B; C.A2 = S.A2; C.B2 = S.B2; C.K = D; C.O2 = (h16*)(p.ws + OFF_MGC); C.O3 = (h16*)(p.ws + OFF_MGC) + (size_t)CTX * D; C.P = S.P; gemm_phase(lds, C, p.wv); }
                        if (l + 1 < DEPTH && !cvt_first) phase_cvt(p, l + 1, lds, gridDim.x > 16 ? 8 : 0); });
                PHASE({ Pol<G_OUT> S{}; S.A = ws + OFF_Y; S.B = (const char*)(Wt + W_O); S.A2 = ws + OFF_MGC; S.B2 = ws + OFF_MGC + (size_t)CTX * D * 2; S.nM = 65; S.nN = 4; S.K = D; S.noctx = (l == DEPTH - 1);
                        S.X = (h16*)(p.ws + OFF_X); S.gate_lat = ml + 5 * D; S.gate_ctx = mc + 5 * D; S.gs = 1.0f; S.PART = (float*)(p.ws + OFF_PART); gemm_phase(lds, S, p.wv); });
                PHASE(DUPP(2, phase_norm(p, l, 2, l + 1 < DEPTH ? 8 : 0)));
            }
            PHASE({ Pol<G_UP> S{}; S.A = ws + OFF_Y; S.B = (const char*)(Wt + (f ? W_UP2 : W_UP1)); S.nM = 65; S.nN = 22; S.K = D; S.O = (h16*)(p.ws + OFF_RA); DUPP(16, gemm_phase(lds, S, p.wv)); });
            PHASE({ Pol<G_DN> S{}; S.A = ws + OFF_RA; S.B = (const char*)(Wt + (f ? W_DN2 : W_DN1)); S.nM = 65; S.nN = 4; S.K = DFF; S.noctx = (f == 1 && l == DEPTH - 1);
                    S.X = (h16*)(p.ws + OFF_X); S.gate_lat = ml + (f ? 8 : 2) * D; S.gate_ctx = mc + (f ? 8 : 2) * D; S.gs = 0.5f; S.PART = (float*)(p.ws + OFF_PART); gemm_phase(lds, S, p.wv); });
        }
    }
    PHASE(phase_final(p));
}
constexpr int N_PHASES = 1 + DEPTH * 13 + 1;

extern "C" void kernel_launch(void* const* d_in, const int* in_sizes, int n_in, void* d_out, int out_size, void* d_ws, size_t ws_size, hipStream_t stream) {
    static int grid_blocks = 0;
    if (grid_blocks == 0) {
        if (n_in != 18 || out_size != SEQ * D || ws_size < WS_END) { fprintf(stderr, "kernel_launch: unexpected shapes / workspace (%d inputs, out %d, ws %zu, need %zu)\n", n_in, out_size, ws_size, (size_t)WS_END); grid_blocks = -1; return; }
        if (hipFuncSetAttribute((const void*)fwd_megakernel, hipFuncAttributeMaxDynamicSharedMemorySize, LDS_BYTES) != hipSuccess) { fprintf(stderr, "kernel_launch: hipFuncSetAttribute failed\n"); grid_blocks = -1; return; }
        int dev = 0, cus = 0, per_cu = 0;
        hipGetDevice(&dev);
        hipDeviceGetAttribute(&cus, hipDeviceAttributeMultiprocessorCount, dev);
        hipOccupancyMaxActiveBlocksPerMultiprocessor(&per_cu, (const void*)fwd_megakernel, 512, LDS_BYTES);
        if (per_cu < 1) { fprintf(stderr, "kernel_launch: occupancy query says %d blocks per CU\n", per_cu); per_cu = 1; }
        (void)hipGetLastError();
        grid_blocks = cus;
    }
    if (grid_blocks < 0) return;
    Params p{};
    p.x = (const float*)d_in[0]; p.c = (const float*)d_in[1]; p.ctx = (const float*)d_in[2]; p.c_ctx = (const float*)d_in[3]; p.norm_w = (const float*)d_in[4];
    p.w_mod = (const float*)d_in[5]; p.b_mod = (const float*)d_in[6]; p.f1u = (const float*)d_in[7]; p.f1d = (const float*)d_in[8]; p.w_in = (const float*)d_in[9];
    p.rld = (const float*)d_in[10]; p.conv_w = (const float*)d_in[11]; p.wro = (const float*)d_in[12]; p.wco = (const float*)d_in[13]; p.wo = (const float*)d_in[14];
    p.f2u = (const float*)d_in[15]; p.f2d = (const float*)d_in[16]; p.fnw = (const float*)d_in[17];
    p.out = (float*)d_out; p.ws = (unsigned char*)d_ws;
#if N_SPLIT
    for (int ph = 0; ph < N_PHASES; ++ph) { p.ph_lo = ph; p.ph_hi = ph + 1; hipLaunchKernelGGL(fwd_megakernel, dim3(grid_blocks), dim3(512), LDS_BYTES, stream, p); }
#else
    p.ph_lo = 0; p.ph_hi = N_PHASES;
    (void)hipMemsetAsync((char*)d_ws + OFF_BAR, 0, 16384, stream);
    void* args[] = {&p};
    hipError_t e = hipLaunchCooperativeKernel((const void*)fwd_megakernel, dim3(grid_blocks), dim3(512), args, LDS_BYTES, stream);
    if (e != hipSuccess) fprintf(stderr, "cooperative launch failed: %s (grid %d)\n", hipGetErrorString(e), grid_blocks);
#endif
}
```

```cpp
#include <hip/hip_runtime.h>
#include <hip/hip_cooperative_groups.h>
#include <cstdio>
namespace cg = cooperative_groups;

#define LAS __attribute__((address_space(3)))
typedef _Float16 h16;
typedef _Float16 h16x8 __attribute__((ext_vector_type(8)));
typedef _Float16 h16x4 __attribute__((ext_vector_type(4)));
typedef _Float16 h16x2 __attribute__((ext_vector_type(2)));
typedef float f32x4 __attribute__((ext_vector_type(4)));
typedef unsigned u32x4 __attribute__((ext_vector_type(4)));

#ifndef DUP_MASK
#define DUP_MASK 0
#endif
#ifndef N_SPLIT
#define N_SPLIT 0
#endif

constexpr int D = 1024, SEQ = 16384, CTX = 256, M = SEQ + CTX, DEPTH = 4, DFF = 2816, NUP = 5632;
constexpr int NCH = M / 128;
constexpr int PW = 6144, WNR = 7168;
constexpr int PC_K = 0, PC_Q = 512, PC_G = 1024, PC_CB = 2048, PC_U = 3072, PC_GR = 4096, PC_GC = 5120;
constexpr float LOG2E = 1.4426950408889634f;
constexpr float NEPS = 1e-6f;

constexpr size_t SZ_X = (size_t)M * D * 2;
constexpr size_t SZ_Y = (size_t)M * D * 2;
constexpr size_t SZ_H = (size_t)M * DFF * 2;
constexpr size_t SZ_SB = (size_t)NCH * 8 * 32768 * 2;
constexpr size_t SZ_KT = (size_t)512 * M * 2;
constexpr size_t SZ_P = (size_t)M * PW * 2;
constexpr size_t SZ_VT = (size_t)1024 * M * 2;
constexpr size_t SZ_AC = (size_t)M * 2048 * 2;
static_assert(SZ_SB + SZ_KT <= SZ_H, "alias");
constexpr size_t OFF_X = 0;
constexpr size_t OFF_Y = OFF_X + SZ_X;
constexpr size_t OFF_RA = OFF_Y + SZ_Y;
constexpr size_t OFF_P = OFF_RA + SZ_H;
constexpr size_t OFF_VT = OFF_P + SZ_P;
constexpr size_t OFF_AC = OFF_VT + SZ_VT;
constexpr size_t OFF_W = OFF_AC + SZ_AC;
constexpr size_t W_UP1 = 0, W_DN1 = W_UP1 + (size_t)NUP * D, W_KV = W_DN1 + (size_t)D * DFF, W_N = W_KV + (size_t)1536 * D,
                 W_RO = W_N + (size_t)WNR * D, W_CO = W_RO + (size_t)D * D, W_O = W_CO + (size_t)D * D, W_UP2 = W_O + (size_t)D * D,
                 W_DN2 = W_UP2 + (size_t)NUP * D, W_END = W_DN2 + (size_t)D * DFF;
constexpr size_t OFF_MOD = OFF_W + 2 * W_END * 2;
constexpr size_t OFF_ROPE = OFF_MOD + (size_t)4 * 2 * 9216 * 4;
constexpr size_t OFF_BAR = OFF_ROPE + (size_t)256 * 32 * 2 * 4;
constexpr size_t OFF_PART = OFF_BAR + 16384;
constexpr size_t OFF_MGC = OFF_PART + (size_t)11 * CTX * D * 4;
constexpr size_t WS_END = OFF_MGC + (size_t)2 * CTX * D * 2;
constexpr int LDS_BYTES = 147456;

struct Params {
    const float* x; const float* c; const float* ctx; const float* c_ctx; const float* norm_w; const float* w_mod; const float* b_mod;
    const float* f1u; const float* f1d; const float* w_in; const float* rld; const float* conv_w; const float* wro; const float* wco; const float* wo;
    const float* f2u; const float* f2d; const float* fnw;
    float* out; unsigned char* ws; int ph_lo, ph_hi;
};
struct Ctx : Params { int wv; };

__device__ __forceinline__ int opaque_tid(int wv) { asm volatile("" : "+s"(wv)); int t = wv * 64 + (int)__builtin_amdgcn_mbcnt_hi(~0u, __builtin_amdgcn_mbcnt_lo(~0u, 0u)); asm volatile("" : "+v"(t)); return t; }
__device__ __forceinline__ int opaque_bid() { int b = blockIdx.x; asm volatile("" : "+s"(b)); return b; }
__device__ __forceinline__ float wave_sum(float v) {
#pragma unroll
    for (int o = 1; o < 64; o <<= 1) v += __shfl_xor(v, o);
    return v;
}
__device__ __forceinline__ float sigm(float x) { return __builtin_amdgcn_rcpf(1.0f + __builtin_amdgcn_exp2f(-x * LOG2E)); }
__device__ __forceinline__ float silu(float x) { return x * sigm(x); }
__device__ __forceinline__ h16x4 cvt4(f32x4 v) { h16x4 o; o.x = (h16)v.x; o.y = (h16)v.y; o.z = (h16)v.z; o.w = (h16)v.w; return o; }

constexpr int BM = 256, BK = 64, HALF = 128, HTB = HALF * BK * 2;
__device__ __forceinline__ int lds_byte(int r, int c) { const int st = (r >> 4) * 2 + (c >> 5), rr = r & 15, cc = c & 31, ob = rr * 64 + cc * 2; return st * 1024 + (ob ^ (((ob >> 9) & 1) << 5)); }
__device__ __forceinline__ void stage_rc(int b, int& R, int& C) { const int st = b / 1024, sb = b % 1024, swz = sb ^ (((sb >> 9) & 1) << 5); R = (st >> 1) * 16 + swz / 64; C = (st & 1) * 32 + (swz % 64) / 2; }
__device__ __forceinline__ void tile_of(int L, int nM, int nN, int& pm, int& pn) {
    const int nwg = nM * nN; int wgid = L;
    { const int q = nwg / 8, r = nwg % 8, xcd = wgid % 8, off = wgid / 8; wgid = (xcd < r ? xcd * (q + 1) : r * (q + 1) + (xcd - r) * q) + off; }
    const int nig = 8 * nN, gid = wgid / nig, fm = gid * 8, gsz = (nM - fm) < 8 ? (nM - fm) : 8;
    pm = __builtin_amdgcn_readfirstlane(fm + ((wgid % nig) % gsz)); pn = __builtin_amdgcn_readfirstlane((wgid % nig) / gsz);
}

struct Unit { const char* A; const char* B; int pm, pn, part, nt; };
typedef f32x4 Acc[2][2][4][2];

enum { G_UP = 0, G_DN = 1, G_INP = 2, G_YG = 3, G_OUT = 4, G_YGC = 5 };

template <int KIND> struct Pol {
    const char* A; const char* B; const char* A2; const char* B2;
    int nM, nN, K, noctx;
    h16* X; const float* gate_lat; const float* gate_ctx; float gs;
    h16* O; h16* O2; h16* O3; const h16* P; const float* cosT; const float* sinT; float* PART;

    __device__ __forceinline__ bool next(int i, Unit& u, int bid) const {
        const int G = gridDim.x, c = bid;
        int L = i * G + c, part = 0;
        const size_t tstep = (size_t)BM * K * 2;
        u.nt = K / BK;
        if (KIND == G_YG) {
            const int Lp = (i >> 1) * G + c; if (Lp >= 256) return false;
            int pm, pn; tile_of(Lp, 64, 4, pm, pn); part = i & 1;
            u.pm = pm + 1; u.pn = pn; u.part = part; u.A = (part ? A2 : A) + (size_t)(pm + 1) * tstep; u.B = (part ? B2 : B) + (size_t)pn * tstep; return true;
        }
        if (KIND == G_YGC) {
            if (L >= 8) return false;
            part = L >> 2; u.pm = 0; u.pn = L & 3; u.part = 2 + part; u.A = part ? A2 : A; u.B = (part ? B2 : B) + (size_t)(L & 3) * tstep; return true;
        }
        if (KIND == G_DN || KIND == G_OUT) {
            const int nlat = 64 * 4, nsl = noctx ? 0 : ((KIND == G_OUT) ? 8 : K / 256);
            if (L >= nlat + 4 * nsl) return false;
            if (L >= nlat) { const int idx = L - nlat, pn = idx & 3, sl = idx >> 2;
                u.pm = 0; u.pn = pn; u.part = 1 + sl; u.nt = 4;
                if (KIND == G_OUT) { u.A = ((sl >> 2) ? B2 : A2) + (size_t)(sl & 3) * 512; u.B = B + (size_t)pn * tstep + (size_t)(sl & 3) * 512; }
                else { u.A = A + (size_t)sl * 512; u.B = B + (size_t)pn * tstep + (size_t)sl * 512; }
                return true; }
            int pm, pn; tile_of(L, 64, 4, pm, pn);
            u.pm = pm + 1; u.pn = pn; u.part = 0; u.A = A + (size_t)(pm + 1) * tstep; u.B = B + (size_t)pn * tstep; return true;
        }
        if (L >= nM * nN) return false;
        int pm, pn; tile_of(L, nM, nN, pm, pn);
        u.pm = pm; u.pn = pn; u.part = part;
        if (KIND == G_INP && pn >= 28) { u.A = A2 + (size_t)(pn - 28) * tstep; u.B = A + (size_t)pm * tstep; }
        else { u.A = A + (size_t)pm * tstep; u.B = B + (size_t)pn * tstep; }
        return true;
    }
    __device__ __forceinline__ bool keep(const Unit& u) const { return KIND == G_YG && u.part == 0; }

    __device__ __forceinline__ void epi(Acc& acc, const Unit& u, int wr, int wc, int fr, int fq) const {
        const int r0 = u.pm * BM + wr * 64 + fr;
        if (KIND == G_UP) {
            const int hc0 = u.pn * 128 + 32 * wc + 8 * fq;
#pragma unroll
            for (int ai = 0; ai < 2; ++ai)
#pragma unroll
                for (int m = 0; m < 4; ++m) { h16x8 o; float e8[8], r8[8];
#pragma unroll
                    for (int n = 0; n < 2; ++n)
#pragma unroll
                        for (int j = 0; j < 4; ++j) e8[4 * n + j] = __builtin_amdgcn_exp2f(-acc[ai][0][m][n][j] * LOG2E);
#pragma unroll
                    for (int q = 0; q < 8; ++q) r8[q] = __builtin_amdgcn_rcpf(1.0f + e8[q]);
#pragma unroll
                    for (int n = 0; n < 2; ++n)
#pragma unroll
                        for (int j = 0; j < 4; ++j) o[4 * n + j] = (h16)(acc[ai][0][m][n][j] * r8[4 * n + j] * acc[ai][1][m][n][j]);
                    *(h16x8*)(O + (size_t)(r0 + ai * HALF + m * 16) * DFF + hc0) = o; }
        } else if (KIND == G_DN || KIND == G_OUT) {
            const int c0 = u.pn * BM + wc * 32 + 8 * fq;
            const float* gate = (u.pm == 0) ? gate_ctx : gate_lat;
            f32x4 g[2][2];
#pragma unroll
            for (int bj = 0; bj < 2; ++bj)
#pragma unroll
                for (int n = 0; n < 2; ++n) g[bj][n] = *(const f32x4*)(gate + c0 + bj * HALF + n * 4) * gs;
            if (u.part) {
#pragma unroll
                for (int ai = 0; ai < 2; ++ai)
#pragma unroll
                    for (int m = 0; m < 4; ++m)
#pragma unroll
                        for (int bj = 0; bj < 2; ++bj)
#pragma unroll
                            for (int n = 0; n < 2; ++n)
                                *(f32x4*)(PART + (size_t)(u.part - 1) * CTX * D + (size_t)(r0 + ai * HALF + m * 16) * D + c0 + bj * HALF + n * 4) = g[bj][n] * acc[ai][bj][m][n];
            } else {
                h16x8 xv[2][4][2];
#pragma unroll
                for (int ai = 0; ai < 2; ++ai)
#pragma unroll
                    for (int m = 0; m < 4; ++m)
#pragma unroll
                        for (int bj = 0; bj < 2; ++bj) xv[ai][m][bj] = *(const h16x8*)(X + (size_t)(r0 + ai * HALF + m * 16) * D + c0 + bj * HALF);
#pragma unroll
                for (int ai = 0; ai < 2; ++ai)
#pragma unroll
                    for (int m = 0; m < 4; ++m)
#pragma unroll
                        for (int bj = 0; bj < 2; ++bj) { const h16x8 x = xv[ai][m][bj]; h16x8 o;
#pragma unroll
                            for (int j = 0; j < 4; ++j) { o[j] = (h16)((float)x[j] + g[bj][0][j] * acc[ai][bj][m][0][j]); o[4 + j] = (h16)((float)x[4 + j] + g[bj][1][j] * acc[ai][bj][m][1][j]); }
                            *(h16x8*)(X + (size_t)(r0 + ai * HALF + m * 16) * D + c0 + bj * HALF) = o; }
            }
        } else if (KIND == G_INP) {
            if (u.pn >= 28) {
                const int ft = u.pn - 28;
                const int t0 = u.pm * BM + wc * 32 + 4 * fq;
                if (ft < 2) {
                    const float ks = 0.08838834764831845f;
#pragma unroll
                    for (int bj = 0; bj < 2; ++bj) { f32x4 csk[2][2], snk[2][2];
#pragma unroll
                        for (int n = 0; n < 2; ++n)
#pragma unroll
                            for (int m = 0; m < 2; ++m) { csk[n][m] = (f32x4){1.f, 1.f, 1.f, 1.f}; snk[n][m] = (f32x4){0.f, 0.f, 0.f, 0.f};
                                if (u.pm > 0) { const int f = 16 * m + fr, nt = t0 + bj * HALF + n * 16 - CTX;
#pragma unroll
                                    for (int j = 0; j < 4; ++j) { const int pos = wr ? ((nt + j) & 63) : ((nt + j) >> 6); csk[n][m][j] = cosT[pos * 32 + f]; snk[n][m][j] = sinT[pos * 32 + f]; } } }
                        __builtin_amdgcn_sched_barrier(0);
#pragma unroll
                        for (int ai = 0; ai < 2; ++ai)
#pragma unroll
                            for (int n = 0; n < 2; ++n) { const int t = t0 + bj * HALF + n * 16;
#pragma unroll
                                for (int m = 0; m < 2; ++m) { const f32x4 a0 = acc[ai][bj][m][n] * ks, b0 = acc[ai][bj][m + 2][n] * ks;
                                    const f32x4 a = a0 * csk[n][m] - b0 * snk[n][m], b = a0 * snk[n][m] + b0 * csk[n][m];
                                    const int F = ft * 256 + ai * HALF + wr * 64 + 16 * m + fr;
                                    *(h16x4*)(O2 + (size_t)F * M + t) = cvt4(a); *(h16x4*)(O2 + (size_t)(F + 32) * M + t) = cvt4(b); } }
                        __builtin_amdgcn_sched_barrier(0); }
                } else {
#pragma unroll
                    for (int ai = 0; ai < 2; ++ai)
#pragma unroll
                        for (int m = 0; m < 4; ++m) { h16* rowp = O3 + (size_t)((ft - 2) * 256 + ai * HALF + wr * 64 + 16 * m + fr) * M + t0;
#pragma unroll
                            for (int bj = 0; bj < 2; ++bj)
#pragma unroll
                                for (int n = 0; n < 2; ++n) *(h16x4*)(rowp + bj * HALF + n * 16) = cvt4(acc[ai][bj][m][n]); }
                }
            } else if (u.pn < 4) {
                const float sc = (u.pn < 2) ? 0.08838834764831845f : 1.0f;
                const int phi0 = 64 * (wc >> 1) + 16 * (wc & 1) + 4 * fq, f0 = 16 * (wc & 1) + 4 * fq;
                const int cb = (u.pn < 2 ? PC_K : PC_Q) + (u.pn & 1) * 256 + phi0;
#pragma unroll
                for (int ai = 0; ai < 2; ++ai) { f32x4 csv[4], snv[4];
#pragma unroll
                    for (int m = 0; m < 4; ++m) { const int row = r0 + ai * HALF + m * 16; csv[m] = (f32x4){1.f, 1.f, 1.f, 1.f}; snv[m] = (f32x4){0.f, 0.f, 0.f, 0.f};
                        if (u.pm > 0) { const int nt = row - CTX, pos = (wc >> 1) ? (nt & 63) : (nt >> 6); csv[m] = *(const f32x4*)(cosT + pos * 32 + f0); snv[m] = *(const f32x4*)(sinT + pos * 32 + f0); } }
                    __builtin_amdgcn_sched_barrier(0);
#pragma unroll
                    for (int m = 0; m < 4; ++m) { const int row = r0 + ai * HALF + m * 16; const f32x4 cs = csv[m], sn = snv[m];
#pragma unroll
                        for (int bj = 0; bj < 2; ++bj) { const f32x4 a = acc[ai][bj][m][0] * sc, b = acc[ai][bj][m][1] * sc;
                            h16* op = O + (size_t)row * PW + cb + bj * HALF;
                            *(h16x4*)op = cvt4(a * cs - b * sn); *(h16x4*)(op + 32) = cvt4(a * sn + b * cs); } }
                    __builtin_amdgcn_sched_barrier(0); }
            } else if (u.pn >= 12 && u.pn < 20) {
                const int c0 = PC_U + (u.pn - 12) * 128 + wc * 32 + 8 * fq;
#pragma unroll
                for (int ai = 0; ai < 2; ++ai)
#pragma unroll
                    for (int m = 0; m < 4; ++m) { h16x8 o;
#pragma unroll
                        for (int j = 0; j < 4; ++j) { o[j] = (h16)(acc[ai][0][m][0][j] * acc[ai][1][m][0][j]); o[4 + j] = (h16)(acc[ai][0][m][1][j] * acc[ai][1][m][1][j]); }
                        *(h16x8*)(O + (size_t)(r0 + ai * HALF + m * 16) * PW + c0) = o; }
            } else {
                const int c0 = (u.pn < 12 ? u.pn * BM : PC_GR + (u.pn - 20) * BM) + wc * 32 + 8 * fq;
#pragma unroll
                for (int ai = 0; ai < 2; ++ai)
#pragma unroll
                    for (int m = 0; m < 4; ++m) { h16* rowp = O + (size_t)(r0 + ai * HALF + m * 16) * PW + c0;
#pragma unroll
                        for (int bj = 0; bj < 2; ++bj) { h16x8 o;
#pragma unroll
                            for (int j = 0; j < 4; ++j) { o[j] = (h16)acc[ai][bj][m][0][j]; o[4 + j] = (h16)acc[ai][bj][m][1][j]; }
                            *(h16x8*)(rowp + bj * HALF) = o; } }
            }
        } else if (KIND == G_YGC) {
            const int c0 = u.pn * BM + wc * 32 + 8 * fq;
            const h16* gp = P + (u.part == 2 ? PC_GR : PC_GC) + c0; h16* op = (u.part == 2 ? O2 : O3) + c0;
#pragma unroll
            for (int ai = 0; ai < 2; ++ai) { h16x8 gv[4][2];
#pragma unroll
                for (int m = 0; m < 4; ++m)
#pragma unroll
                    for (int bj = 0; bj < 2; ++bj) gv[m][bj] = *(const h16x8*)(gp + (size_t)(r0 + ai * HALF + m * 16) * PW + bj * HALF);
                __builtin_amdgcn_sched_barrier(0);
#pragma unroll
                for (int m = 0; m < 4; ++m) { const size_t row = (size_t)(r0 + ai * HALF + m * 16);
#pragma unroll
                    for (int bj = 0; bj < 2; ++bj) { const h16x8 g = gv[m][bj]; h16x8 o;
#pragma unroll
                        for (int n = 0; n < 2; ++n)
#pragma unroll
                            for (int j = 0; j < 4; ++j) o[4 * n + j] = (h16)(acc[ai][bj][m][n][j] * sigm(fmaxf((float)g[4 * n + j], -30.f)));
                        *(h16x8*)(op + row * D + bj * HALF) = o; } }
                __builtin_amdgcn_sched_barrier(0); }
        } else if (KIND == G_YG) {
            const int c0 = u.pn * BM + wc * 32 + 8 * fq;
            if (u.part == 0) {
#pragma unroll
                for (int ai = 0; ai < 2; ++ai) { h16x8 gr[4][2], gc[4][2];
#pragma unroll
                    for (int m = 0; m < 4; ++m)
#pragma unroll
                        for (int bj = 0; bj < 2; ++bj) { const h16* gp = P + (size_t)(r0 + ai * HALF + m * 16) * PW + c0 + bj * HALF;
                            gr[m][bj] = *(const h16x8*)(gp + PC_GR); gc[m][bj] = *(const h16x8*)(gp + PC_GC); }
                    __builtin_amdgcn_sched_barrier(0);
#pragma unroll
                    for (int m = 0; m < 4; ++m)
#pragma unroll
                        for (int bj = 0; bj < 2; ++bj)
#pragma unroll
                            for (int n = 0; n < 2; ++n) { f32x4 q;
#pragma unroll
                                for (int j = 0; j < 4; ++j) { const float er = __builtin_amdgcn_exp2f(-fmaxf((float)gr[m][bj][4 * n + j], -30.f) * LOG2E), ec = __builtin_amdgcn_exp2f(-fmaxf((float)gc[m][bj][4 * n + j], -30.f) * LOG2E);
                                    q[j] = (1.0f + ec) * __builtin_amdgcn_rcpf(1.0f + er); }
                                acc[ai][bj][m][n] = acc[ai][bj][m][n] * q; } }
            } else {
#pragma unroll
                for (int ai = 0; ai < 2; ++ai) { h16x8 gv[4][2];
#pragma unroll
                    for (int m = 0; m < 4; ++m)
#pragma unroll
                        for (int bj = 0; bj < 2; ++bj) gv[m][bj] = *(const h16x8*)(P + (size_t)(r0 + ai * HALF + m * 16) * PW + PC_GC + c0 + bj * HALF);
                    __builtin_amdgcn_sched_barrier(0);
#pragma unroll
                    for (int m = 0; m < 4; ++m) { const size_t row = (size_t)(r0 + ai * HALF + m * 16);
#pragma unroll
                        for (int bj = 0; bj < 2; ++bj) { const h16x8 gc = gv[m][bj]; h16x8 o;
#pragma unroll
                            for (int n = 0; n < 2; ++n)
#pragma unroll
                                for (int j = 0; j < 4; ++j) o[4 * n + j] = (h16)(acc[ai][bj][m][n][j] * sigm(fmaxf((float)gc[4 * n + j], -30.f)));
                            *(h16x8*)(O + row * D + c0 + bj * HALF) = o; } }
                    __builtin_amdgcn_sched_barrier(0); }
            }
        }
    }
};

template <class P_> __device__ __forceinline__ void gemm_phase(LAS unsigned char* lds, const P_& S, int wv_) {
    const int tid = opaque_tid(wv_), wid = __builtin_amdgcn_readfirstlane(tid >> 6), lane = tid & 63, wr = wid >> 2, wc = wid & 3, fr = lane & 15, fq = lane >> 4;
    const int K = S.K;
    unsigned voff[2];
#pragma unroll
    for (int i = 0; i < 2; ++i) { int R, C; stage_rc(tid * 16 + i * 8192, R, C); voff[i] = (unsigned)(R * K + C) * 2u; }
    const size_t kstep = (size_t)(BK * 2), hstep = (size_t)HALF * K * 2;
    const unsigned ldsw = (unsigned)wid * 1024u;
    const int aoff = lds_byte(wr * 64 + fr, fq * 8), boff = lds_byte(wc * 32 + fr, fq * 8);
#define G_SA(b, h) (((b) * 2 + (h)) * HTB)
#define G_SB(b, h) ((4 + (b) * 2 + (h)) * HTB)
#define G_STAGE(bufoff, gbase) do { _Pragma("unroll") for (int _i = 0; _i < 2; ++_i) \
        __builtin_amdgcn_global_load_lds((const unsigned*)((const char*)(gbase) + voff[_i]), (LAS unsigned*)(lds + (bufoff) + ldsw + _i * 8192), 16, 0, 0); } while (0)
#define G_LDA(dst, b, h) do { _Pragma("unroll") for (int m = 0; m < 4; ++m) _Pragma("unroll") for (int k = 0; k < 2; ++k) dst[m][k] = *(const LAS h16x8*)(lds + G_SA(b, h) + aoff + m * 2048 + k * 1024); } while (0)
#define G_LDB(dst, b, h) do { _Pragma("unroll") for (int n = 0; n < 2; ++n) _Pragma("unroll") for (int k = 0; k < 2; ++k) dst[n][k] = *(const LAS h16x8*)(lds + G_SB(b, h) + boff + n * 2048 + k * 1024); } while (0)
#define G_MMA(ai, bj, At, Bt) do { __builtin_amdgcn_s_setprio(1); _Pragma("unroll") for (int m = 0; m < 4; ++m) _Pragma("unroll") for (int n = 0; n < 2; ++n) _Pragma("unroll") for (int k = 0; k < 2; ++k) \
        acc[ai][bj][m][n] = __builtin_amdgcn_mfma_f32_16x16x32_f16(Bt[n][k], At[m][k], acc[ai][bj][m][n], 0, 0, 0); __builtin_amdgcn_s_setprio(0); } while (0)
#define G_WAIT_V(n) asm volatile("s_waitcnt vmcnt(" #n ")" ::: "memory")
#define G_WAIT_L(n) asm volatile("s_waitcnt lgkmcnt(" #n ")" ::: "memory")
#define G_BAR __builtin_amdgcn_s_barrier()
#define G_SCHED __builtin_amdgcn_sched_barrier(0)
    Unit cur, nxt; int ui = 0;
    const int bid = opaque_bid();
    if (!S.next(0, cur, bid)) return;
    Acc acc;
#pragma unroll
    for (int a = 0; a < 2; ++a)
#pragma unroll
        for (int b = 0; b < 2; ++b)
#pragma unroll
            for (int m = 0; m < 4; ++m)
#pragma unroll
                for (int n = 0; n < 2; ++n) acc[a][b][m][n] = (f32x4){0.f, 0.f, 0.f, 0.f};
    h16x8 At[4][2], B0[2][2], B1[2][2];
    const char* cA = cur.A; const char* cB = cur.B;
    G_STAGE(G_SB(0, 0), cB); G_STAGE(G_SA(0, 0), cA); G_STAGE(G_SB(0, 1), cB + hstep); G_STAGE(G_SA(0, 1), cA + hstep);
    if (wr == 1) G_BAR;
    G_WAIT_V(4); G_BAR;
    G_STAGE(G_SB(1, 0), cB + kstep); G_STAGE(G_SA(1, 0), cA + kstep); G_STAGE(G_SB(1, 1), cB + hstep + kstep);
    G_WAIT_V(6); G_BAR;
    for (;;) {
        const bool has_next = S.next(ui + 1, nxt, bid);
        const char* nA = has_next ? nxt.A : cA; const char* nB = has_next ? nxt.B : cB;
        const int nt = cur.nt;
        for (int t = 0; t < nt; t += 2) {
            const bool last = (t == nt - 2);
            const char* a1 = cA + (size_t)(t + 1) * kstep;
            const char* a2 = last ? nA : cA + (size_t)(t + 2) * kstep; const char* b2 = last ? nB : cB + (size_t)(t + 2) * kstep;
            const char* a3 = a2 + kstep; const char* b3 = b2 + kstep;
            G_LDB(B0, 0, 0); G_SCHED; G_LDA(At, 0, 0); G_STAGE(G_SA(1, 1), a1 + hstep);
            G_WAIT_L(8); G_BAR; G_WAIT_L(0); G_MMA(0, 0, At, B0); G_BAR; G_SCHED;
            G_LDB(B1, 0, 1); G_STAGE(G_SB(0, 0), b2);
            G_BAR; G_WAIT_L(0); G_MMA(0, 1, At, B1); G_BAR;
            G_LDA(At, 0, 1); G_STAGE(G_SA(0, 0), a2);
            G_BAR; G_WAIT_L(0); G_MMA(1, 0, At, B0); G_BAR; G_SCHED;
            G_STAGE(G_SB(0, 1), b2 + hstep);
            G_WAIT_V(6); G_BAR; G_MMA(1, 1, At, B1); G_BAR;
            G_LDB(B0, 1, 0); G_SCHED; G_LDA(At, 1, 0); G_STAGE(G_SA(0, 1), a2 + hstep);
            G_WAIT_L(8); G_BAR; G_WAIT_L(0); G_MMA(0, 0, At, B0); G_BAR; G_SCHED;
            G_LDB(B1, 1, 1); G_STAGE(G_SB(1, 0), b3);
            G_BAR; G_WAIT_L(0); G_MMA(0, 1, At, B1); G_BAR;
            G_LDA(At, 1, 1); G_STAGE(G_SA(1, 0), a3);
            G_BAR; G_WAIT_L(0); G_MMA(1, 0, At, B0); G_BAR; G_SCHED;
            G_STAGE(G_SB(1, 1), b3 + hstep);
            G_WAIT_V(6); G_BAR; G_MMA(1, 1, At, B1); G_BAR;
        }
        S.epi(acc, cur, wr, wc, fr, fq);
        if (!S.keep(cur)) {
#pragma unroll
            for (int a = 0; a < 2; ++a)
#pragma unroll
                for (int b = 0; b < 2; ++b)
#pragma unroll
                    for (int m = 0; m < 4; ++m)
#pragma unroll
                        for (int n = 0; n < 2; ++n) acc[a][b][m][n] = (f32x4){0.f, 0.f, 0.f, 0.f};
        }
        if (!has_next) break;
        cur = nxt; cA = nA; cB = nB; ++ui;
    }
    G_WAIT_V(0);
    if (wr == 0) G_BAR;
    G_BAR;
}

__device__ __forceinline__ void phase_setup(const Ctx& p, LAS unsigned char* lds) {
    const int tid = opaque_tid(p.wv), nb = gridDim.x, b = opaque_bid();
    float* cosT = (float*)(p.ws + OFF_ROPE); float* sinT = cosT + 256 * 32;
    for (int i = b * 512 + tid; i < 256 * 32; i += nb * 512) {
        const int pos = i >> 5, f = i & 31;
        const float inv = exp2f(-(float)f * (13.287712379549449f / 32.0f));
        const float ang = (float)pos * inv;
        const double rev = (double)ang * 0.15915494309189535;
        const float fr = (float)(rev - floor(rev));
        cosT[i] = __builtin_amdgcn_cosf(fr); sinT[i] = __builtin_amdgcn_sinf(fr);
    }
    float* mod = (float*)(p.ws + OFF_MOD);
    LAS float* red = (LAS float*)lds;
    for (int it = b; it < 4 * 144; it += nb) {
        const int l = it / 144, cgp = it % 144, ct = tid & 15, sl = tid >> 4;
        const float* wm = p.w_mod + (size_t)l * D * 9216 + cgp * 64 + ct * 4;
        f32x4 ax = {0.f, 0.f, 0.f, 0.f}, ac = {0.f, 0.f, 0.f, 0.f};
#pragma unroll 8
        for (int r = 0; r < 32; ++r) { const int i = sl * 32 + r; const float cx = p.c[i], cc = p.c_ctx[i];
            const float sx = cx / (1.0f + expf(-cx)), sc = cc / (1.0f + expf(-cc));
            const f32x4 w = *(const f32x4*)(wm + (size_t)i * 9216); ax += w * sx; ac += w * sc; }
        *(LAS f32x4*)(red + (sl * 16 + ct) * 8) = ax; *(LAS f32x4*)(red + (sl * 16 + ct) * 8 + 4) = ac;
        __syncthreads();
        if (tid < 128) { const int s = tid >> 6, cc = tid & 63, ct2 = cc >> 2, comp = cc & 3; float sum = 0.f;
#pragma unroll 8
            for (int q = 0; q < 32; ++q) sum += red[(q * 16 + ct2) * 8 + s * 4 + comp];
            const int col = cgp * 64 + cc; mod[(size_t)(l * 2 + s) * 9216 + col] = sum + p.b_mod[(size_t)l * 9216 + col]; }
        __syncthreads();
    }
}

__device__ __forceinline__ int slot32(int s32) { return 16 * ((s32 >> 2) & 1) + 4 * (s32 >> 3) + (s32 & 3); }
__device__ __forceinline__ int perm_row(int kind, int s) {
    if (kind == 1) { const int part = s / DFF, hidx = s % DFF, pn = hidx >> 7, rem = hidx & 127; return pn * 256 + part * 128 + (rem & ~31) + slot32(rem & 31); }
    if (kind == 2) { const int head = s >> 7, phi = s & 127; return head * 128 + 32 * (2 * (phi >> 6) + ((phi & 31) >> 4)) + 16 * ((phi & 63) >> 5) + (phi & 15); }
    if (kind == 3) return (s & ~31) + slot32(s & 31);
    if (kind == 4) { const int part = s >> 10, ch = s & 1023, t = ch >> 7, rem = ch & 127; return t * 256 + part * 128 + (rem & ~31) + slot32(rem & 31); }
    return s;
}
__device__ __forceinline__ void cvt_job(const float* W, int ldw, int c0, int ncols, int K, h16* WT, int kind, LAS float* scr, int gw, int NGW, int lane) {
    const int nblk = ncols / 32, nitems = (K / 64) * nblk;
    f32x4 pre[8];
    if (gw < nitems) { const int kb = gw / nblk, nbk = gw % nblk;
#pragma unroll
        for (int i = 0; i < 8; ++i) pre[i] = *(const f32x4*)(W + (size_t)(64 * kb + 8 * i + (lane >> 3)) * ldw + c0 + 32 * nbk + (lane & 7) * 4); }
    for (int item = gw; item < nitems; item += NGW) {
        const int kb = item / nblk, nbk = item % nblk, k0 = 64 * kb, n0 = 32 * nbk;
#pragma unroll
        for (int i = 0; i < 8; ++i) { const int kk = 8 * i + (lane >> 3), nn = (lane & 7) * 4; const f32x4 v = pre[i];
            scr[kk * 33 + nn] = v.x; scr[kk * 33 + nn + 1] = v.y; scr[kk * 33 + nn + 2] = v.z; scr[kk * 33 + nn + 3] = v.w; }
        if (item + NGW < nitems) { const int kb2 = (item + NGW) / nblk, nbk2 = (item + NGW) % nblk;
#pragma unroll
            for (int i = 0; i < 8; ++i) pre[i] = *(const f32x4*)(W + (size_t)(64 * kb2 + 8 * i + (lane >> 3)) * ldw + c0 + 32 * nbk2 + (lane & 7) * 4); }
        asm volatile("s_waitcnt lgkmcnt(0)" ::: "memory");
        const int c = lane & 7;
#pragma unroll
        for (int j = 0; j < 4; ++j) { const int n = (lane >> 3) + 8 * j; const LAS float* s = scr + (8 * c) * 33 + n;
            h16x8 o;
#pragma unroll
            for (int e = 0; e < 8; ++e) o[e] = (h16)s[e * 33];
            *(h16x8*)(WT + (size_t)perm_row(kind, n0 + n) * K + k0 + 8 * c) = o; }
        asm volatile("s_waitcnt lgkmcnt(0)" ::: "memory");
    }
}
__device__ __forceinline__ void phase_cvt(const Ctx& p, int l, LAS unsigned char* lds, int skip) {
    const int tid = opaque_tid(p.wv), wv = tid >> 6, lane = tid & 63, bid = opaque_bid(), gw = (bid - skip) * 8 + wv, NGW = ((int)gridDim.x - skip) * 8;
    if (bid < skip) return;
    LAS float* scr = (LAS float*)(lds + wv * 8448);
    h16* W = (h16*)(p.ws + OFF_W) + (size_t)(l & 1) * W_END;
    const float* win = p.w_in + (size_t)l * D * 8192;
    cvt_job(p.f1u + (size_t)l * D * NUP, NUP, 0, NUP, D, W + W_UP1, 1, scr, gw, NGW, lane);
    cvt_job(p.f1d + (size_t)l * DFF * D, D, 0, D, DFF, W + W_DN1, 3, scr, gw, NGW, lane);
    cvt_job(win, 8192, 0, 1536, D, W + W_KV, 0, scr, gw, NGW, lane);
    cvt_job(win, 8192, 0, 512, D, W + W_N, 2, scr, gw, NGW, lane);
    cvt_job(win, 8192, 1536, 512, D, W + W_N + (size_t)512 * D, 2, scr, gw, NGW, lane);
    cvt_job(win, 8192, 2048, 2048, D, W + W_N + (size_t)1024 * D, 3, scr, gw, NGW, lane);
    cvt_job(win, 8192, 4096, 2048, D, W + W_N + (size_t)3072 * D, 4, scr, gw, NGW, lane);
    cvt_job(win, 8192, 6144, 2048, D, W + W_N + (size_t)5120 * D, 3, scr, gw, NGW, lane);
    cvt_job(p.wro + (size_t)l * D * D, D, 0, D, D, W + W_RO, 3, scr, gw, NGW, lane);
    cvt_job(p.wco + (size_t)l * D * D, D, 0, D, D, W + W_CO, 3, scr, gw, NGW, lane);
    cvt_job(p.wo + (size_t)l * D * D, D, 0, D, D, W + W_O, 3, scr, gw, NGW, lane);
    cvt_job(p.f2u + (size_t)l * D * NUP, NUP, 0, NUP, D, W + W_UP2, 1, scr, gw, NGW, lane);
    cvt_job(p.f2d + (size_t)l * DFF * D, D, 0, D, DFF, W + W_DN2, 3, scr, gw, NGW, lane);
}

__device__ __forceinline__ void phase_norm(const Ctx& p, int l, int sub, int nsl, bool first = false) {
    const int tid = opaque_tid(p.wv), lane = tid & 63, gw = opaque_bid() * 8 + (tid >> 6), NGW = gridDim.x * 8;
    h16* X = (h16*)(p.ws + OFF_X); h16* Y = (h16*)(p.ws + OFF_Y); const float* PART = (const float*)(p.ws + OFF_PART);
    const float* nw = p.norm_w + (size_t)(l * 3 + sub) * D;
    const float* mod = (const float*)(p.ws + OFF_MOD);
    const float* ml = mod + (size_t)(l * 2) * 9216; const float* mc = ml + 9216;
#define NCOL(j) (8 * lane + 512 * ((j) >> 1) + 4 * ((j) & 1))
    f32x4 wl[4], sl4[4];
#pragma unroll
    for (int j = 0; j < 4; ++j) { const int col = NCOL(j);
        wl[j] = *(const f32x4*)(nw + col) * (*(const f32x4*)(ml + (3 * sub + 1) * D + col) + 1.0f); sl4[j] = *(const f32x4*)(ml + (3 * sub) * D + col); }
    h16x8 tn[2];
    if (!first && gw < M) { tn[0] = *(const h16x8*)(X + (size_t)gw * D + 8 * lane); tn[1] = *(const h16x8*)(X + (size_t)gw * D + 8 * lane + 512); }
    for (int row = gw; row < M; row += NGW) {
        h16* xrow = X + (size_t)row * D; h16* yrow = Y + (size_t)row * D;
        f32x4 v[4]; float ss = 0.f;
        if (first) { const float* x32 = row < CTX ? p.ctx + (size_t)row * D : p.x + (size_t)(row - CTX) * D;
#pragma unroll
            for (int j = 0; j < 4; ++j) v[j] = *(const f32x4*)(x32 + NCOL(j));
#pragma unroll
            for (int q = 0; q < 2; ++q) { h16x8 o;
#pragma unroll
                for (int e = 0; e < 4; ++e) { o[e] = (h16)v[2 * q][e]; o[4 + e] = (h16)v[2 * q + 1][e]; }
                *(h16x8*)(xrow + 8 * lane + 512 * q) = o; }
        } else {
#pragma unroll
            for (int q = 0; q < 2; ++q) { const h16x8 t = tn[q];
#pragma unroll
                for (int e = 0; e < 4; ++e) { v[2 * q][e] = (float)t[e]; v[2 * q + 1][e] = (float)t[4 + e]; } }
            if (row + NGW < M) { tn[0] = *(const h16x8*)(xrow + (size_t)NGW * D + 8 * lane); tn[1] = *(const h16x8*)(xrow + (size_t)NGW * D + 8 * lane + 512); }
        }
        const bool isctx = row < CTX;
        if (isctx && nsl > 0) {
            for (int s0 = 0; s0 < nsl; s0 += 4) { f32x4 pv[4][4];
#pragma unroll
                for (int q = 0; q < 4; ++q) { const int sl = (s0 + q < nsl) ? s0 + q : nsl - 1; const float* pr = PART + (size_t)sl * CTX * D + (size_t)row * D;
#pragma unroll
                    for (int j = 0; j < 4; ++j) pv[q][j] = *(const f32x4*)(pr + NCOL(j)); }
#pragma unroll
                for (int q = 0; q < 4; ++q) if (s0 + q < nsl) {
#pragma unroll
                    for (int j = 0; j < 4; ++j) v[j] += pv[q][j]; } }
#pragma unroll
            for (int q = 0; q < 2; ++q) { h16x8 o;
#pragma unroll
                for (int e = 0; e < 4; ++e) { o[e] = (h16)v[2 * q][e]; o[4 + e] = (h16)v[2 * q + 1][e]; }
                *(h16x8*)(xrow + 8 * lane + 512 * q) = o; }
        }
#pragma unroll
        for (int j = 0; j < 4; ++j) ss += v[j].x * v[j].x + v[j].y * v[j].y + v[j].z * v[j].z + v[j].w * v[j].w;
        ss = wave_sum(ss);
        const float rs = __builtin_amdgcn_rsqf(ss * (1.0f / D) + NEPS);
        f32x4 y[4];
        if (isctx) {
#pragma unroll
            for (int j = 0; j < 4; ++j) { const int col = NCOL(j);
                const f32x4 w = *(const f32x4*)(nw + col), sc = *(const f32x4*)(mc + (3 * sub + 1) * D + col), sh = *(const f32x4*)(mc + (3 * sub) * D + col);
                y[j] = (v[j] * rs) * w * (sc + 1.0f) + sh; }
        } else {
#pragma unroll
            for (int j = 0; j < 4; ++j) y[j] = (v[j] * rs) * wl[j] + sl4[j];
        }
#pragma unroll
        for (int q = 0; q < 2; ++q) { h16x8 o;
#pragma unroll
            for (int e = 0; e < 4; ++e) { o[e] = (h16)y[2 * q][e]; o[4 + e] = (h16)y[2 * q + 1][e]; }
            *(h16x8*)(yrow + 8 * lane + 512 * q) = o; }
    }
#undef NCOL
}
__device__ __forceinline__ void phase_final(const Ctx& p) {
    const int tid = opaque_tid(p.wv), lane = tid & 63, gw = opaque_bid() * 8 + (tid >> 6), NGW = gridDim.x * 8;
    const h16* X = (const h16*)(p.ws + OFF_X);
    f32x4 fw[4];
#pragma unroll
    for (int j = 0; j < 4; ++j) fw[j] = *(const f32x4*)(p.fnw + 8 * lane + 512 * (j >> 1) + 4 * (j & 1));
    h16x8 tn[2];
    if (gw < SEQ) { tn[0] = *(const h16x8*)(X + (size_t)(gw + CTX) * D + 8 * lane); tn[1] = *(const h16x8*)(X + (size_t)(gw + CTX) * D + 8 * lane + 512); }
    for (int row = gw; row < SEQ; row += NGW) {
        const h16* xrow = X + (size_t)(row + CTX) * D;
        f32x4 v[4]; float ss = 0.f;
        const h16x8 tc0 = tn[0], tc1 = tn[1];
        if (row + NGW < SEQ) { tn[0] = *(const h16x8*)(xrow + (size_t)NGW * D + 8 * lane); tn[1] = *(const h16x8*)(xrow + (size_t)NGW * D + 8 * lane + 512); }
#pragma unroll
        for (int q = 0; q < 2; ++q) { const h16x8 t = q ? tc1 : tc0;
#pragma unroll
            for (int e = 0; e < 4; ++e) { v[2 * q][e] = (float)t[e]; v[2 * q + 1][e] = (float)t[4 + e]; } }
#pragma unroll
        for (int j = 0; j < 4; ++j) ss += v[j].x * v[j].x + v[j].y * v[j].y + v[j].z * v[j].z + v[j].w * v[j].w;
        ss = wave_sum(ss);
        const float rs = __builtin_amdgcn_rsqf(ss * (1.0f / D) + NEPS);
#pragma unroll
        for (int j = 0; j < 4; ++j) { const int col = 8 * lane + 512 * (j >> 1) + 4 * (j & 1);
            *(f32x4*)(p.out + (size_t)row * D + col) = (v[j] * rs) * fw[j]; }
    }
}

#define MFMA16(a, b, c) __builtin_amdgcn_mfma_f32_16x16x32_f16(a, b, c, 0, 0, 0)

__device__ __forceinline__ void phase_kv(const Ctx& p, int l, LAS unsigned char* lds) {
    const int tid = opaque_tid(p.wv), w = tid >> 6, lane = tid & 63, fr = lane & 15, fq = lane >> 4, bid = opaque_bid();
    LAS h16* Vs = (LAS h16*)lds; LAS h16* Kf = Vs + 256 * 136; LAS h16* Kb = Kf + 128 * 136; LAS float* wt = (LAS float*)(Kb + 128 * 136);
    const h16* kT = (const h16*)(p.ws + OFF_RA + SZ_SB); const h16* vT = (const h16*)(p.ws + OFF_VT); h16* SB = (h16*)(p.ws + OFF_RA);
    u32x4 vreg[8]; h16x8 kreg[4];
#define KV_ISSUE(uu) do { const int _c = (uu) >> 2, _h = (uu) & 3; \
        _Pragma("unroll") for (int i = 0; i < 8; ++i) { const int ch = tid + 512 * i, r = ch >> 4, cc = ch & 15; vreg[i] = *(const u32x4*)(vT + (size_t)(_h * 256 + r) * M + _c * 128 + cc * 8); } \
        _Pragma("unroll") for (int i = 0; i < 4; ++i) { const int ch = tid + 512 * i, r = ch >> 4, cc = ch & 15; kreg[i] = *(const h16x8*)(kT + (size_t)(_h * 128 + r) * M + _c * 128 + cc * 8); } } while (0)
    if (bid < NCH * 4) KV_ISSUE(bid);
    for (int u = bid; u < NCH * 4; u += gridDim.x) {
        const int c = u >> 2, h = u & 3;
        const float lgf = p.rld[(l * 2 + 0) * 4 + h] * LOG2E, lgb = p.rld[(l * 2 + 1) * 4 + h] * LOG2E;
        if (tid < 128) { wt[tid] = exp2f(lgf * (float)(127 - tid)); wt[128 + tid] = exp2f(lgb * (float)tid); }
#pragma unroll
        for (int i = 0; i < 8; ++i) { const int ch = tid + 512 * i, r = ch >> 4, cc = ch & 15; *(LAS u32x4*)(Vs + r * 136 + cc * 8) = vreg[i]; }
        __syncthreads();
#pragma unroll
        for (int i = 0; i < 4; ++i) { const int ch = tid + 512 * i, r = ch >> 4, cc = ch & 15, rs = (r & ~31) + slot32(r & 31);
            const h16x8 k = kreg[i]; h16x8 a, b2;
#pragma unroll
            for (int e = 0; e < 8; ++e) { const float kv = (float)k[e]; a[e] = (h16)(kv * wt[cc * 8 + e]); b2[e] = (h16)(kv * wt[128 + cc * 8 + e]); }
            *(LAS h16x8*)(Kf + rs * 136 + cc * 8) = a; *(LAS h16x8*)(Kb + rs * 136 + cc * 8) = b2; }
        __syncthreads();
        if (u + (int)gridDim.x < NCH * 4) KV_ISSUE(u + (int)gridDim.x);
#pragma unroll 1
        for (int dir = 0; dir < 2; ++dir) {
            const LAS h16* Kd = dir ? Kb : Kf;
            f32x4 acc[2][8];
#pragma unroll
            for (int a = 0; a < 2; ++a)
#pragma unroll
                for (int b = 0; b < 8; ++b) acc[a][b] = (f32x4){0.f, 0.f, 0.f, 0.f};
#pragma unroll
            for (int ks = 0; ks < 4; ++ks) { h16x8 vf[2];
#pragma unroll
                for (int ef = 0; ef < 2; ++ef) vf[ef] = *(const LAS h16x8*)(Vs + (32 * w + 16 * ef + fr) * 136 + ks * 32 + fq * 8);
#pragma unroll
                for (int df = 0; df < 8; ++df) { const h16x8 a = *(const LAS h16x8*)(Kd + (16 * df + fr) * 136 + ks * 32 + fq * 8);
#pragma unroll
                    for (int ef = 0; ef < 2; ++ef) acc[ef][df] = MFMA16(a, vf[ef], acc[ef][df]); } }
#pragma unroll
            for (int ef = 0; ef < 2; ++ef)
#pragma unroll
                for (int dp = 0; dp < 4; ++dp) { h16x8 o;
#pragma unroll
                    for (int j = 0; j < 4; ++j) { o[j] = (h16)acc[ef][2 * dp][j]; o[4 + j] = (h16)acc[ef][2 * dp + 1][j]; }
                    *(h16x8*)(SB + (size_t)(c * 8 + h * 2 + dir) * 32768 + (32 * w + 16 * ef + fr) * 128 + 32 * dp + 8 * fq) = o; }
        }
        __syncthreads();
    }
#undef KV_ISSUE
    const h16* P = (const h16*)(p.ws + OFF_P); h16* Aconv = (h16*)(p.ws + OFF_AC) + (size_t)M * D;
    const int tq = tid >> 7, ch = (tid & 127) * 8;
    float w0[8], w1[8], w2[8];
#pragma unroll
    for (int e = 0; e < 8; ++e) { w0[e] = p.conv_w[(size_t)(l * 3 + 0) * D + ch + e]; w1[e] = p.conv_w[(size_t)(l * 3 + 1) * D + ch + e]; w2[e] = p.conv_w[(size_t)(l * 3 + 2) * D + ch + e]; }
    for (int it = (int)gridDim.x - 1 - bid; it < M / 64; it += gridDim.x) {
        const int t0 = it * 64 + 16 * tq;
        h16x8 ur[18], cbr[16];
        const h16x8 zero8 = {0, 0, 0, 0, 0, 0, 0, 0};
        ur[0] = (t0 == 0 || t0 == CTX) ? zero8 : *(const h16x8*)(P + (size_t)(t0 - 1) * PW + PC_U + ch);
#pragma unroll
        for (int k = 1; k < 17; ++k) ur[k] = *(const h16x8*)(P + (size_t)(t0 - 1 + k) * PW + PC_U + ch);
        ur[17] = (t0 + 16 == CTX || t0 + 16 == M) ? zero8 : *(const h16x8*)(P + (size_t)(t0 + 16) * PW + PC_U + ch);
#pragma unroll
        for (int k = 0; k < 16; ++k) cbr[k] = *(const h16x8*)(P + (size_t)(t0 + k) * PW + PC_CB + ch);
#pragma unroll
        for (int k = 0; k < 16; ++k) { h16x8 o;
#pragma unroll
            for (int e = 0; e < 8; ++e) o[e] = (h16)((float)cbr[k][e] * (w0[e] * (float)ur[k][e] + w1[e] * (float)ur[k + 1][e] + w2[e] * (float)ur[k + 2][e]));
            *(h16x8*)(Aconv + (size_t)(t0 + k) * D + ch) = o; }
    }
}

template <int DIR> __device__ __forceinline__ void scan_chain(h16x2* base, float Dc) {
#define SCAN_IDX(kk) (DIR ? ((kk) < 2 ? 1 - (kk) : NCH + 1 - (kk)) : (kk))
    float r0 = 0.f, r1 = 0.f;
    h16x2 cur[26], nxt[26];
#pragma unroll
    for (int k = 0; k < 26; ++k) cur[k] = base[(size_t)SCAN_IDX(k) * 131072];
#pragma unroll
    for (int bt = 0; bt < NCH / 26; ++bt) {
        if (bt + 1 < NCH / 26) {
#pragma unroll
            for (int k = 0; k < 26; ++k) nxt[k] = base[(size_t)SCAN_IDX(26 * (bt + 1) + k) * 131072]; }
        __builtin_amdgcn_sched_barrier(0);
#pragma unroll
        for (int k = 0; k < 26; ++k) { h16x2 o; o.x = (h16)r0; o.y = (h16)r1; base[(size_t)SCAN_IDX(26 * bt + k) * 131072] = o;
            r0 = Dc * r0 + (float)cur[k].x; r1 = Dc * r1 + (float)cur[k].y; }
        if (bt + 1 < NCH / 26) {
#pragma unroll
            for (int k = 0; k < 26; ++k) cur[k] = nxt[k]; }
    }
#undef SCAN_IDX
}
__device__ __forceinline__ void phase_scan(const Ctx& p, int l) {
    h16x2* SB = (h16x2*)(p.ws + OFF_RA);
    for (int g = opaque_bid() * 512 + opaque_tid(p.wv); g < 131072; g += gridDim.x * 512) {
        const int hd = g >> 14, pi = g & 16383, h = hd >> 1, dir = hd & 1;
        const float Dc = exp2f(p.rld[(l * 2 + dir) * 4 + h] * LOG2E * 128.0f);
        h16x2* base = SB + (size_t)hd * 16384 + pi;
        if (dir) scan_chain<1>(base, Dc); else scan_chain<0>(base, Dc);
    }
}

__device__ __forceinline__ void phase_ret(const Ctx& p, int l, LAS unsigned char* lds) {
    const int tid = opaque_tid(p.wv), w = tid >> 6, lane = tid & 63, fr = lane & 15, fq = lane >> 4, bid = opaque_bid();
    LAS h16* Ks = (LAS h16*)lds; LAS h16* Ps = Ks + 128 * 136; LAS h16* Bb = Ps + 128 * 136;
    const h16* P = (const h16*)(p.ws + OFF_P); const h16* vT = (const h16*)(p.ws + OFF_VT); const h16* SB = (const h16*)(p.ws + OFF_RA);
    h16* Aret = (h16*)(p.ws + OFF_AC);
    const int u0 = (l == DEPTH - 1) ? 8 : 0;
    for (int u = bid + u0; u < NCH * 4; u += gridDim.x) {
        const int c = u >> 2, h = u & 3, row0 = c * 128, il = 16 * w + fr;
        const float lgf = p.rld[(l * 2 + 0) * 4 + h] * LOG2E, lgb = p.rld[(l * 2 + 1) * 4 + h] * LOG2E;
        h16x8 qf[4];
        { const h16* qp = P + (size_t)(row0 + il) * PW + PC_Q + h * 128 + fq * 8;
#pragma unroll
          for (int ks = 0; ks < 4; ++ks) qf[ks] = *(const h16x8*)(qp + ks * 32); }
#pragma unroll
        for (int i = 0; i < 4; ++i) { const int ch = tid + 512 * i, r = ch >> 4, cc = ch & 15;
            *(LAS u32x4*)(Ks + r * 136 + cc * 8) = *(const u32x4*)(P + (size_t)(row0 + r) * PW + PC_K + h * 128 + cc * 8); }
        u32x4 breg[4];
#define RET_LOADB(hb) do { const int _eh = (hb) & 1; const h16* _b; size_t _st; \
            if ((hb) < 2) { _b = vT + (size_t)(h * 256 + 128 * _eh) * M + row0; _st = M; } \
            else { _b = SB + (size_t)(c * 8 + h * 2 + (((hb) >> 1) - 1)) * 32768 + (size_t)(128 * _eh) * 128; _st = 128; } \
            _Pragma("unroll") for (int i = 0; i < 4; ++i) { const int ch = tid + 512 * i, r = ch >> 4, cc = ch & 15; breg[i] = *(const u32x4*)(_b + (size_t)r * _st + cc * 8); } } while (0)
        RET_LOADB(0);
        __syncthreads();
        f32x4 s[8];
#pragma unroll
        for (int n = 0; n < 8; ++n) { s[n] = (f32x4){0.f, 0.f, 0.f, 0.f};
#pragma unroll
            for (int ks = 0; ks < 4; ++ks) s[n] = MFMA16(*(const LAS h16x8*)(Ks + (16 * n + fr) * 136 + ks * 32 + fq * 8), qf[ks], s[n]); }
#pragma unroll
        for (int n = 0; n < 8; ++n) { f32x4 v;
#pragma unroll
            for (int j = 0; j < 4; ++j) { const int rel = il - (16 * n + 4 * fq + j);
                const float mk = rel > 0 ? __builtin_amdgcn_exp2f(lgf * (float)rel) : (rel < 0 ? __builtin_amdgcn_exp2f(lgb * (float)(-rel)) : 2.0f);
                v[j] = s[n][j] * mk; }
            *(LAS h16x4*)(Ps + il * 136 + 16 * n + 4 * fq) = cvt4(v); }
        const h16 wqf = (h16)exp2f(lgf * (float)(il + 1)), wqb = (h16)exp2f(lgb * (float)(128 - il));
        f32x4 o[16];
#pragma unroll
        for (int n = 0; n < 16; ++n) o[n] = (f32x4){0.f, 0.f, 0.f, 0.f};
#pragma unroll 1
        for (int hp = 0; hp < 3; ++hp) {
            h16x8 af[4];
            if (hp == 0) {
#pragma unroll
                for (int ks = 0; ks < 4; ++ks) af[ks] = *(const LAS h16x8*)(Ps + il * 136 + ks * 32 + fq * 8);
            } else { const h16 wq = hp == 1 ? wqf : wqb;
#pragma unroll
                for (int ks = 0; ks < 4; ++ks) af[ks] = qf[ks] * wq; }
#pragma unroll
            for (int eh = 0; eh < 2; ++eh) {
                const int hb = hp * 2 + eh;
                LAS h16* B = Bb + eh * (128 * 136);
#pragma unroll
                for (int i = 0; i < 4; ++i) { const int ch = tid + 512 * i, r = ch >> 4, cc = ch & 15; *(LAS u32x4*)(B + ((r & ~31) + slot32(r & 31)) * 136 + cc * 8) = breg[i]; }
                if (hb < 5) RET_LOADB(hb + 1);
                __syncthreads();
#pragma unroll
                for (int nf = 0; nf < 8; ++nf)
#pragma unroll
                    for (int ks = 0; ks < 4; ++ks) o[eh * 8 + nf] = MFMA16(*(const LAS h16x8*)(B + (16 * nf + fr) * 136 + ks * 32 + fq * 8), af[ks], o[eh * 8 + nf]);
            }
        }
        float ss = 0.f;
#pragma unroll
        for (int n = 0; n < 16; ++n) ss += o[n].x * o[n].x + o[n].y * o[n].y + o[n].z * o[n].z + o[n].w * o[n].w;
        ss += __shfl_xor(ss, 16); ss += __shfl_xor(ss, 32);
        const float rs = __builtin_amdgcn_rsqf(ss * (1.0f / 256.0f) + NEPS);
        const h16* gp = P + (size_t)(row0 + il) * PW + PC_G + h * 256 + 8 * fq; h16* op = Aret + (size_t)(row0 + il) * D + h * 256 + 8 * fq;
        h16x8 gq[8];
#pragma unroll
        for (int np = 0; np < 8; ++np) gq[np] = *(const h16x8*)(gp + 32 * np);
        __builtin_amdgcn_sched_barrier(0);
#pragma unroll
        for (int np = 0; np < 8; ++np) { const h16x8 g = gq[np]; h16x8 v;
#pragma unroll
            for (int j = 0; j < 4; ++j) { v[j] = (h16)(silu((float)g[j]) * o[2 * np][j] * rs); v[4 + j] = (h16)(silu((float)g[4 + j]) * o[2 * np + 1][j] * rs); }
            *(h16x8*)(op + 32 * np) = v; }
        __syncthreads();
    }
}

#define XB_TMO      128
#define XB_XCNT(j)  (256  + 64 * (j))
#define XB_XSUB(j)  (1280 + 64 * (j))
#define XB_XGEN(j)  (2304 + 64 * (j))
#define XB_TOP      3328
#define XB_TOPGEN   3392
#define XB_WORDS    3456
#define XB_SPIN_CAP (1u << 20)
__device__ __forceinline__ unsigned xb_ld(unsigned* p) { return __hip_atomic_load(p, __ATOMIC_RELAXED, __HIP_MEMORY_SCOPE_AGENT); }
__device__ __forceinline__ unsigned xb_add(unsigned* p, unsigned v) { return __hip_atomic_fetch_add(p, v, __ATOMIC_RELAXED, __HIP_MEMORY_SCOPE_AGENT); }
__device__ __forceinline__ unsigned xb_xcc_id() { return (unsigned)__builtin_amdgcn_s_getreg((3 << 11) | 20) & 0xFu; }
#define XB_SPIN(cond, bar) do { unsigned _sp = 0; while (cond) { __builtin_amdgcn_s_sleep(1); \
    if ((++_sp & 255u) == 0u) { if (xb_ld(&(bar)[XB_TMO])) break; if (_sp > XB_SPIN_CAP) { atomicAdd(&(bar)[XB_TMO], 1u); break; } } } } while (0)
__device__ __forceinline__ void grid_barrier(unsigned* bar, volatile LAS unsigned* st, int wv) {
    asm volatile("s_waitcnt vmcnt(0)" ::: "memory");
    __syncthreads();
    if (opaque_tid(wv) == 0) {
        __builtin_amdgcn_s_waitcnt(0);
        const unsigned x = xb_xcc_id();
        unsigned nloc = st[0], nx = st[1];
        if (nloc == 0u) {
            const unsigned G = gridDim.x; unsigned sum, cnt, mine, sp = 0u;
            for (;;) { sum = 0u; cnt = 0u; mine = 0u;
#pragma unroll
                for (unsigned j = 0; j < 16; ++j) { const unsigned c = xb_ld(&bar[XB_XCNT(j)]); sum += c; cnt += (c > 0u) ? 1u : 0u; mine = (j == x) ? c : mine; }
                if (sum == G) break;
                __builtin_amdgcn_s_sleep(1);
                if ((++sp & 255u) == 0u) { if (xb_ld(&bar[XB_TMO])) break; if (sp > XB_SPIN_CAP) { atomicAdd(&bar[XB_TMO], 1u); break; } } }
            nloc = mine > 0u ? mine : 1u; nx = cnt > 0u ? cnt : 1u; st[0] = nloc; st[1] = nx; }
        const unsigned old = xb_add(&bar[XB_XSUB(x)], 1u);
        const unsigned gen = old / nloc;
        if (old + 1u == (gen + 1u) * nloc) {
            __builtin_amdgcn_fence(__ATOMIC_RELEASE, "agent");
            asm volatile("s_waitcnt vmcnt(0)" ::: "memory");
            const unsigned og = xb_add(&bar[XB_TOP], 1u);
            const unsigned tg = og / nx;
            if (og + 1u == (tg + 1u) * nx) xb_add(&bar[XB_TOPGEN], 1u);
            else XB_SPIN(xb_ld(&bar[XB_TOPGEN]) == tg, bar);
            __builtin_amdgcn_fence(__ATOMIC_ACQUIRE, "agent");
            xb_add(&bar[XB_XGEN(x)], 1u);
            asm volatile("s_waitcnt vmcnt(0)" ::: "memory");
        } else {
            XB_SPIN(xb_ld(&bar[XB_XGEN(x)]) == gen, bar);
            __builtin_amdgcn_fence(__ATOMIC_ACQUIRE, "agent");
            asm volatile("s_waitcnt vmcnt(0)" ::: "memory");
        }
    }
    __syncthreads();
}
__global__ void __launch_bounds__(512, 2) fwd_megakernel(Params p0) {
    extern __shared__ __attribute__((aligned(16))) unsigned char smem[];
    LAS unsigned char* lds = (LAS unsigned char*)smem;
    Ctx p; *(Params*)&p = p0; p.wv = __builtin_amdgcn_readfirstlane(threadIdx.x >> 6);
    if (p.ph_hi < 0) cg::this_grid().sync();
    unsigned* bar = (unsigned*)(p.ws + OFF_BAR);
    volatile LAS unsigned* st = (volatile LAS unsigned*)(lds + LDS_BYTES - 16);
    if (threadIdx.x == 0) { st[0] = 0u; st[1] = 0u; (void)xb_add(&bar[XB_XCNT(xb_xcc_id())], 1u); }
    __syncthreads();
    int ph = 0;
#define DUPP(bit, ...) do { __VA_ARGS__; if (DUP_MASK & (bit)) { __VA_ARGS__; } } while (0)
#define PHASE(...) do { if (ph >= p.ph_lo && ph < p.ph_hi) { if (ph > p.ph_lo) grid_barrier(bar, st, p.wv); __VA_ARGS__; } ++ph; } while (0)
    const char* ws = (const char*)p.ws;
    const float* mod = (const float*)(p.ws + OFF_MOD);
    const float* cosT = (const float*)(p.ws + OFF_ROPE); const float* sinT = cosT + 256 * 32;
    PHASE({ phase_setup(p, lds); phase_cvt(p, 0, lds, 0); });
#pragma unroll 1
    for (int l = 0; l < DEPTH; ++l) {
        const float* ml = mod + (size_t)(l * 2) * 9216; const float* mc = ml + 9216;
        const h16* Wt = (const h16*)(p.ws + OFF_W) + (size_t)(l & 1) * W_END;
        PHASE(phase_norm(p, l, 0, l ? 11 : 0, l == 0));
#pragma unroll 1
        for (int f = 0; f < 2; ++f) {
            if (f == 1) {
                PHASE(DUPP(2, phase_norm(p, l, 1, 11)));
                PHASE({ Pol<G_INP> S{}; S.A = ws + OFF_Y; S.B = (const char*)(Wt + W_N); S.A2 = (const char*)(Wt + W_KV); S.nM = 65; S.nN = 34; S.K = D;
                        S.O = (h16*)(p.ws + OFF_P); S.O2 = (h16*)(p.ws + OFF_RA + SZ_SB); S.O3 = (h16*)(p.ws + OFF_VT); S.cosT = cosT; S.sinT = sinT; DUPP(32, gemm_phase(lds, S, p.wv)); });
                PHASE(DUPP(4, phase_kv(p, l, lds)));
                PHASE(phase_scan(p, l));
                PHASE(DUPP(8, phase_ret(p, l, lds)));
                PHASE({ Pol<G_YG> S{}; S.A = ws + OFF_AC; S.B = (const char*)(Wt + W_RO); S.A2 = ws + OFF_AC + (size_t)M * D * 2; S.B2 = (const char*)(Wt + W_CO); S.nM = 65; S.nN = 4; S.K = D;
                        S.O = (h16*)(p.ws + OFF_Y); S.P = (const h16*)(p.ws + OFF_P);
                        const bool cvt_first = (l + 1 < DEPTH) && (blockIdx.x & 1);
                        if (cvt_first) { phase_cvt(p, l + 1, lds, gridDim.x > 16 ? 8 : 0); __syncthreads(); }
                        DUPP(64, gemm_phase(lds, S, p.wv));
                        if (l + 1 < DEPTH) { Pol<G_YGC> C{}; C.A = S.A; C.B = S.B; C.A2 = S.A2; C.B2 = S.B2; C.K = D; C.O2 = (h16*)(p.ws + OFF_MGC); C.O3 = (h16*)(p.ws + OFF_MGC) + (size_t)CTX * D; C.P = S.P; gemm_phase(lds, C, p.wv); }
                        if (l + 1 < DEPTH && !cvt_first) phase_cvt(p, l + 1, lds, gridDim.x > 16 ? 8 : 0); });
                PHASE({ Pol<G_OUT> S{}; S.A = ws + OFF_Y; S.B = (const char*)(Wt + W_O); S.A2 = ws + OFF_MGC; S.B2 = ws + OFF_MGC + (size_t)CTX * D * 2; S.nM = 65; S.nN = 4; S.K = D; S.noctx = (l == DEPTH - 1);
                        S.X = (h16*)(p.ws + OFF_X); S.gate_lat = ml + 5 * D; S.gate_ctx = mc + 5 * D; S.gs = 1.0f; S.PART = (float*)(p.ws + OFF_PART); gemm_phase(lds, S, p.wv); });
                PHASE(DUPP(2, phase_norm(p, l, 2, l + 1 < DEPTH ? 8 : 0)));
            }
            PHASE({ Pol<G_UP> S{}; S.A = ws + OFF_Y; S.B = (const char*)(Wt + (f ? W_UP2 : W_UP1)); S.nM = 65; S.nN = 22; S.K = D; S.O = (h16*)(p.ws + OFF_RA); DUPP(16, gemm_phase(lds, S, p.wv)); });
            PHASE({ Pol<G_DN> S{}; S.A = ws + OFF_RA; S.B = (const char*)(Wt + (f ? W_DN2 : W_DN1)); S.nM = 65; S.nN = 4; S.K = DFF; S.noctx = (f == 1 && l == DEPTH - 1);
                    S.X = (h16*)(p.ws + OFF_X); S.gate_lat = ml + (f ? 8 : 2) * D; S.gate_ctx = mc + (f ? 8 : 2) * D; S.gs = 0.5f; S.PART = (float*)(p.ws + OFF_PART); gemm_phase(lds, S, p.wv); });
        }
    }
    PHASE(phase_final(p));
}
constexpr int N_PHASES = 1 + DEPTH * 13 + 1;

extern "C" void kernel_launch(void* const* d_in, const int* in_sizes, int n_in, void* d_out, int out_size, void* d_ws, size_t ws_size, hipStream_t stream) {
    static int grid_blocks = 0;
    if (grid_blocks == 0) {
        if (n_in != 18 || out_size != SEQ * D || ws_size < WS_END) { fprintf(stderr, "kernel_launch: unexpected shapes / workspace (%d inputs, out %d, ws %zu, need %zu)\n", n_in, out_size, ws_size, (size_t)WS_END); grid_blocks = -1; return; }
        if (hipFuncSetAttribute((const void*)fwd_megakernel, hipFuncAttributeMaxDynamicSharedMemorySize, LDS_BYTES) != hipSuccess) { fprintf(stderr, "kernel_launch: hipFuncSetAttribute failed\n"); grid_blocks = -1; return; }
        int dev = 0, cus = 0, per_cu = 0;
        hipGetDevice(&dev);
        hipDeviceGetAttribute(&cus, hipDeviceAttributeMultiprocessorCount, dev);
        hipOccupancyMaxActiveBlocksPerMultiprocessor(&per_cu, (const void*)fwd_megakernel, 512, LDS_BYTES);
        if (per_cu < 1) { fprintf(stderr, "kernel_launch: occupancy query says %d blocks per CU\n", per_cu); per_cu = 1; }
        (void)hipGetLastError();
        grid_blocks = cus;
    }
    if (grid_blocks < 0) return;
    Params p{};
    p.x = (const float*)d_in[0]; p.c = (const float*)d_in[1]; p.ctx = (const float*)d_in[2]; p.c_ctx = (const float*)d_in[3]; p.norm_w = (const float*)d_in[4];
    p.w_mod = (const float*)d_in[5]; p.b_mod = (const float*)d_in[6]; p.f1u = (const float*)d_in[7]; p.f1d = (const float*)d_in[8]; p.w_in = (const float*)d_in[9];
    p.rld = (const float*)d_in[10]; p.conv_w = (const float*)d_in[11]; p.wro = (const float*)d_in[12]; p.wco = (const float*)d_in[13]; p.wo = (const float*)d_in[14];
    p.f2u = (const float*)d_in[15]; p.f2d = (const float*)d_in[16]; p.fnw = (const float*)d_in[17];
    p.out = (float*)d_out; p.ws = (unsigned char*)d_ws;
#if N_SPLIT
    for (int ph = 0; ph < N_PHASES; ++ph) { p.ph_lo = ph; p.ph_hi = ph + 1; hipLaunchKernelGGL(fwd_megakernel, dim3(grid_blocks), dim3(512), LDS_BYTES, stream, p); }
#else
    p.ph_lo = 0; p.ph_hi = N_PHASES;
    (void)hipMemsetAsync((char*)d_ws + OFF_BAR, 0, 16384, stream);
    void* args[] = {&p};
    hipError_t e = hipLaunchCooperativeKernel((const void*)fwd_megakernel, dim3(grid_blocks), dim3(512), args, LDS_BYTES, stream);
    if (e != hipSuccess) fprintf(stderr, "cooperative launch failed: %s (grid %d)\n", hipGetErrorString(e), grid_blocks);
#endif
}
```
